# Optimizing an MI355X kernel written in HIP

```python
import math
import jax, jax.numpy as jnp
from jax import lax
import numpy as np

D_MODEL = 1024
BATCH = 32
SEQ = 2048
DEPTH = 1

PLE_DIM = 256
N_DIFF_HEADS = 8
DIFF_HEAD_DIM = 64
DIFF_V_DIM = 2 * DIFF_HEAD_DIM
N_RET_HEADS = 4
RET_KEY_DIM = 128
RET_VAL_DIM = 2 * RET_KEY_DIM
D_FF = 4 * D_MODEL
Q_BLOCK = 128
RET_CHUNK = 128
EPS = 1e-6

DIFF_QK_W = N_DIFF_HEADS * 2 * DIFF_HEAD_DIM
DIFF_V_W = N_DIFF_HEADS * DIFF_V_DIM
RET_QK_W = N_RET_HEADS * RET_KEY_DIM
RET_V_W = N_RET_HEADS * RET_VAL_DIM
IN_SPLITS = (DIFF_QK_W, DIFF_QK_W, DIFF_V_W,
             RET_QK_W, RET_QK_W, RET_V_W, RET_V_W,
             D_MODEL, D_MODEL)
D_IN = sum(IN_SPLITS)

kernel_name = "hybrid_diffattn_retention_gated_block"


def rms_norm(x, g):
    xf = x.astype(jnp.float32)
    y = xf * lax.rsqrt(jnp.mean(xf * xf, axis=-1, keepdims=True) + EPS)
    return (y * g.astype(jnp.float32)).astype(x.dtype)


def alibi_slopes(n_heads):
    return 2.0 ** (-8.0 * jnp.arange(1, n_heads + 1, dtype=jnp.float32) / n_heads)


def diff_attention(q, k, v, lam):
    B, S, H, _, d = q.shape
    e = v.shape[-1]
    n_blocks = S // Q_BLOCK
    scale = d ** -0.5
    kpos = jnp.arange(S)
    slopes = alibi_slopes(H)[:, None, None, None]

    def block(i):
        start = i * Q_BLOCK
        qb = lax.dynamic_slice_in_dim(q, start, Q_BLOCK, axis=1)
        s = jnp.einsum('bqhcd,bkhcd->bhcqk', qb, k).astype(jnp.float32) * scale
        qpos = start + jnp.arange(Q_BLOCK)
        dist = (qpos[:, None] - kpos[None, :]).astype(jnp.float32)
        logits = jnp.where(dist >= 0, s - slopes * dist, -jnp.inf)
        probs = jax.nn.softmax(logits, axis=-1)
        a = probs[:, :, 0] - lam * probs[:, :, 1]
        return jnp.einsum('bhqk,bkhe->bqhe', a.astype(v.dtype), v)

    out = lax.map(block, jnp.arange(n_blocks))
    return out.transpose(1, 0, 2, 3, 4).reshape(B, S, H, e)


def retention(q, k, v):
    B, S, H, dk = q.shape
    dv = v.shape[-1]
    C = RET_CHUNK
    n_chunks = S // C
    dt = q.dtype
    log_gamma = jnp.log(1.0 - 2.0 ** (-5.0 - jnp.arange(H, dtype=jnp.float32)))
    pos = jnp.arange(C, dtype=jnp.float32)
    rel = pos[:, None] - pos[None, :]
    decay_intra = jnp.where(rel >= 0, jnp.exp(log_gamma[:, None, None] * rel), 0.0).astype(dt)
    q_decay = jnp.exp(log_gamma[None, :] * (pos[:, None] + 1.0)).astype(dt)
    k_decay = jnp.exp(log_gamma[:, None] * (C - 1.0 - pos[None, :])).astype(dt)
    chunk_decay = jnp.exp(log_gamma * C).astype(dt)

    k = k * (dk ** -0.5)
    to_chunks = lambda t: t.reshape(B, n_chunks, C, H, t.shape[-1]).transpose(1, 0, 2, 3, 4)
    qc, kc, vc = to_chunks(q), to_chunks(k), to_chunks(v)

    def step(R, inp):
        qi, ki, vi = inp
        s = jnp.einsum('bnhk,bmhk->bhnm', qi, ki) * decay_intra
        intra = jnp.einsum('bhnm,bmhv->bnhv', s, vi)
        cross = jnp.einsum('bnhk,bhkv->bnhv', qi, R) * q_decay[None, :, :, None]
        R_new = R * chunk_decay[None, :, None, None] + jnp.einsum('bmhk,bmhv,hm->bhkv', ki, vi, k_decay)
        return R_new, intra + cross

    R0 = jnp.zeros((B, H, dk, dv), dt)
    _, out = lax.scan(step, R0, (qc, kc, vc))
    return out.transpose(1, 0, 2, 3, 4).reshape(B, S, H, dv)


def setup_inputs(seed: int = 0) -> dict:
    key = jax.random.key(seed)
    ks = jax.random.split(key, 24)
    f32 = jnp.float32
    nrm = lambda k, shape, s: (jax.random.normal(k, shape, f32) * s)
    gain = lambda k, shape: 1.0 + 0.02 * jax.random.normal(k, shape, f32)
    L = DEPTH
    return {
        "x": nrm(ks[0], (BATCH, SEQ, D_MODEL), 1.0),
        "p": nrm(ks[1], (DEPTH, BATCH, SEQ, PLE_DIM), 1.0),
        "g_mix": gain(ks[2], (L, D_MODEL)),
        "w_in": nrm(ks[3], (L, D_MODEL, D_IN), D_MODEL ** -0.5),
        "lam_q1": nrm(ks[4], (L, DIFF_HEAD_DIM), 0.1),
        "lam_k1": nrm(ks[5], (L, DIFF_HEAD_DIM), 0.1),
        "lam_q2": nrm(ks[6], (L, DIFF_HEAD_DIM), 0.1),
        "lam_k2": nrm(ks[7], (L, DIFF_HEAD_DIM), 0.1),
        "g_diff_sub": gain(ks[8], (L, DIFF_V_DIM)),
        "g_ret_sub": gain(ks[9], (L, N_RET_HEADS, RET_VAL_DIM)),
        "w_branch_diff": nrm(ks[10], (L, DIFF_V_W, D_MODEL), DIFF_V_W ** -0.5),
        "w_branch_ret": nrm(ks[11], (L, RET_V_W, D_MODEL), RET_V_W ** -0.5),
        "w_out": nrm(ks[12], (L, D_MODEL, D_MODEL), D_MODEL ** -0.5),
        "g_mlp": gain(ks[13], (L, D_MODEL)),
        "w_ff1": nrm(ks[14], (L, D_MODEL, D_FF), D_MODEL ** -0.5),
        "w_ff2": nrm(ks[15], (L, D_FF, D_MODEL), D_FF ** -0.5),
        "g_ple": gain(ks[16], (L, D_MODEL)),
        "w_ple_gate": nrm(ks[17], (L, D_MODEL, D_MODEL), D_MODEL ** -0.5),
        "w_ple": nrm(ks[18], (L, PLE_DIM, D_MODEL), PLE_DIM ** -0.5),
        "g_final": gain(ks[19], (D_MODEL,)),
    }


def reference(x, p, g_mix, w_in, lam_q1, lam_k1, lam_q2, lam_k2, g_diff_sub, g_ret_sub,
              w_branch_diff, w_branch_ret, w_out, g_mlp, w_ff1, w_ff2, g_ple, w_ple_gate,
              w_ple, g_final):
    B, S, _ = x.shape
    split_idx = list(np.cumsum(IN_SPLITS)[:-1])
    for i in range(DEPTH):
        h = rms_norm(x, g_mix[i])
        proj = h @ w_in[i]
        qa, ka, va, qr, kr, vr, gr, gate_a, gate_r = jnp.split(proj, split_idx, axis=-1)

        lam_init = 0.8 - 0.6 * math.exp(-0.3 * i)
        lam = (jnp.exp(jnp.sum(lam_q1[i] * lam_k1[i]).astype(jnp.float32))
               - jnp.exp(jnp.sum(lam_q2[i] * lam_k2[i]).astype(jnp.float32)) + lam_init)
        qa = qa.reshape(B, S, N_DIFF_HEADS, 2, DIFF_HEAD_DIM)
        ka = ka.reshape(B, S, N_DIFF_HEADS, 2, DIFF_HEAD_DIM)
        va = va.reshape(B, S, N_DIFF_HEADS, DIFF_V_DIM)
        ya = diff_attention(qa, ka, va, lam)
        ya = (rms_norm(ya, g_diff_sub[i]) * (1.0 - lam_init)).reshape(B, S, DIFF_V_W)

        qr = qr.reshape(B, S, N_RET_HEADS, RET_KEY_DIM)
        kr = kr.reshape(B, S, N_RET_HEADS, RET_KEY_DIM)
        vr = vr.reshape(B, S, N_RET_HEADS, RET_VAL_DIM)
        yr = rms_norm(retention(qr, kr, vr), g_ret_sub[i]).reshape(B, S, RET_V_W)
        yr = jax.nn.silu(gr) * yr

        mixed = (jax.nn.sigmoid(gate_a) * (ya @ w_branch_diff[i])
                 + jax.nn.sigmoid(gate_r) * (yr @ w_branch_ret[i]))
        x = x + mixed @ w_out[i]

        h2 = rms_norm(x, g_mlp[i])
        x = x + jnp.square(jax.nn.relu(h2 @ w_ff1[i])) @ w_ff2[i]

        gate_p = jax.nn.sigmoid(rms_norm(x, g_ple[i]) @ w_ple_gate[i])
        x = x + gate_p * (p[i] @ w_ple[i])
    return rms_norm(x, g_final)
```

```cpp
#include <hip/hip_runtime.h>
#include <cstdint>
#include <cstdio>

#ifndef MK_PER_PHASE
#define MK_PER_PHASE 0
#endif

typedef unsigned short bf16;
typedef unsigned u32x4 __attribute__((ext_vector_type(4)));
typedef unsigned u32x2 __attribute__((ext_vector_type(2)));
typedef float f32x4 __attribute__((ext_vector_type(4)));
typedef float f32x2 __attribute__((ext_vector_type(2)));
#define LAS __attribute__((address_space(3)))
#define GAS __attribute__((address_space(1)))

constexpr int D = 1024, NB = 32, S = 2048, PLE = 256, DIN = 8192, FF = 4096, M = NB * S;
constexpr int MG = M;
constexpr int PP = 6144;
constexpr float EPS = 1e-6f;
constexpr int O_QA = 0, O_KA = 1024, O_VA = 2048, O_QR = 3072, O_KR = 3584, O_VR = 4096, O_GR = 5120, O_GA = 1024, O_GB = 2048;
constexpr int W_GATE_ROW = 6144;
constexpr float LOG2E = 1.4426950408889634f;
constexpr float QA_SCALE = 0.125f * LOG2E;
constexpr float KR_SCALE = 0.08838834764831845f;
constexpr int RCH = 32;
constexpr float LAM_INIT = 0.2f;

constexpr size_t MiB = 1u << 20;
constexpr size_t WS_CTL = 0, CTL_ZERO_BYTES = 128 * 1024;
constexpr size_t WS_WIN = 1 * MiB, WS_WBD = 17 * MiB, WS_WBR = 19 * MiB, WS_WOUT = 21 * MiB, WS_W1 = 23 * MiB, WS_W2 = 31 * MiB, WS_WPG = 39 * MiB, WS_WPLE = 41 * MiB;
constexpr size_t WS_SS = 44 * MiB;
constexpr size_t WS_MIX = 56 * MiB;
constexpr size_t WS_PROJ = 184 * MiB;
constexpr size_t WS_END = 952 * MiB;
constexpr int CW_BAR = 4096;

__device__ __forceinline__ float bf2f(bf16 v) { return __uint_as_float((unsigned)v << 16); }
__device__ __forceinline__ bf16 f2bf(float f) { unsigned u = __float_as_uint(f); return (bf16)((u + 0x7fffu + ((u >> 16) & 1u)) >> 16); }
__device__ __forceinline__ unsigned pk2(float lo, float hi) { return (unsigned)f2bf(lo) | ((unsigned)f2bf(hi) << 16); }
__device__ __forceinline__ float wave_sum(float v) {
#pragma unroll
    for (int o = 1; o < 64; o <<= 1) v += __shfl_xor(v, o);
    return v;
}
__device__ __forceinline__ float wave_max(float v) {
#pragma unroll
    for (int o = 1; o < 64; o <<= 1) v = fmaxf(v, __shfl_xor(v, o));
    return v;
}
__device__ __forceinline__ float sum_fq(float v) {
    { auto r = __builtin_amdgcn_permlane16_swap(__float_as_uint(v), __float_as_uint(v), false, false); v = __uint_as_float(r[0]) + __uint_as_float(r[1]); }
    { auto r = __builtin_amdgcn_permlane32_swap(__float_as_uint(v), __float_as_uint(v), false, false); v = __uint_as_float(r[0]) + __uint_as_float(r[1]); }
    return v; }
__device__ __forceinline__ float sigmoidf_(float v) { return __builtin_amdgcn_rcpf(1.f + __builtin_amdgcn_exp2f(-v * LOG2E)); }
__device__ __forceinline__ float ret_log2gamma(int h) { return h == 0 ? -0.04580368961312479f : h == 1 ? -0.02272007650008353f : h == 2 ? -0.011315313227834146f : -0.005646563141142063f; }
#define LDS_WAIT() asm volatile("s_waitcnt lgkmcnt(0)" ::: "memory")

namespace pg8 {
#define PG8_LAS __attribute__((address_space(3)))
typedef unsigned short bf16_t;
typedef short bf16x8 __attribute__((ext_vector_type(8)));
constexpr int BM = 256, BK = 64, HALF = 128, HTB = HALF * BK * 2, STAGE_BYTES = 8 * HTB, NXCD = 8, WGM = 8;
__host__ __device__ __forceinline__ int lds_byte(int r, int c) { const int st = (r >> 4) * 2 + (c >> 5), rr = r & 15, cc = c & 31, ob = rr * 64 + cc * 2; return st * 1024 + (ob ^ (((ob >> 9) & 1) << 5)); }
__host__ __device__ __forceinline__ void stage_rc(int b, int& R, int& C) { const int st = b / 1024, sb = b % 1024, swz = sb ^ (((sb >> 9) & 1) << 5); R = (st >> 1) * 16 + swz / 64; C = (st & 1) * 32 + (swz % 64) / 2; }
__host__ __device__ __forceinline__ int perm32(int rho) { const int n = rho >> 4, i = rho & 15; return 8 * (i >> 2) + 4 * n + (i & 3); }

struct Unit { int pm, pn, z; };
struct Gemm { const bf16_t* A0; const bf16_t* B0; const bf16_t* A1; const bf16_t* B1; int lda, ldb, K0, K1; };

struct StaticOrder {
    int nM, nN, nwg, G, c, nz;
    __host__ __device__ void init(int M_, int N_, int G_, int c_, int nz_) { nM = M_ / BM; nN = N_ / BM; nwg = nM * nN; G = G_; c = c_; nz = nz_; }
    __host__ __device__ bool next(int i, Unit& u) const {
        const int ti = i / nz; u.z = i - ti * nz;
        const long L = (long)ti * G + c; if (L >= nwg) return false;
        int wgid = (int)L; { const int q = nwg / NXCD, r = nwg % NXCD, xcd = wgid % NXCD, off = wgid / NXCD; wgid = (xcd < r ? xcd * (q + 1) : r * (q + 1) + (xcd - r) * q) + off; }
        const int nig = WGM * nN, gid = wgid / nig, fm = gid * WGM, gsz = (nM - fm) < WGM ? (nM - fm) : WGM;
        u.pm = fm + ((wgid % nig) % gsz); u.pn = (wgid % nig) / gsz; return true;
    }
};
__device__ __forceinline__ unsigned cvt_pk_bf16(float lo, float hi) { unsigned r; asm volatile("v_cvt_pk_bf16_f32 %0, %1, %2" : "=v"(r) : "v"(lo), "v"(hi)); return r; }

template <class Epi, bool ALIGN_EPI>
__device__ __forceinline__ void gemm_phase(PG8_LAS unsigned char* lds, const Gemm g, const StaticOrder& S, const Epi& E) {
    int tid_ = threadIdx.x; asm volatile("" : "+v"(tid_));
    const int tid = tid_, wid = __builtin_amdgcn_readfirstlane(tid >> 6), lane = tid & 63, wr = wid >> 2, wc = wid & 3, fr = lane & 15, fq = lane >> 4;
    unsigned voffA[2], voffB[2];
#pragma unroll
    for (int i = 0; i < 2; ++i) { int R, C; stage_rc(tid * 16 + i * 8192, R, C); const int Rb = Epi::PERM ? ((R & ~31) + perm32(R & 31)) : R;
        voffA[i] = (unsigned)(R * g.lda + C) * 2u; voffB[i] = (unsigned)(Rb * g.ldb + C) * 2u; }
    const size_t kstep = (size_t)(BK * 2);
    const size_t hstepA = (size_t)HALF * g.lda * 2, hstepB = (size_t)HALF * g.ldb * 2;
    const size_t tstepA = 2 * hstepA, tstepB = 2 * hstepB;
    const unsigned ldsw = (unsigned)wid * 1024u;
    const int aoff = lds_byte(wr * 64 + fr, fq * 8), boff = lds_byte(wc * 32 + fr, fq * 8);
#define PG8_SA(b, h) (((b) * 2 + (h)) * HTB)
#define PG8_SB(b, h) ((4 + (b) * 2 + (h)) * HTB)
#define PG8_STAGE(bufoff, gbase, voff) do { _Pragma("unroll") for (int _i = 0; _i < 2; ++_i) \
        __builtin_amdgcn_global_load_lds((const unsigned*)((const char*)(gbase) + (voff)[_i]), (PG8_LAS unsigned*)(lds + (bufoff) + ldsw + _i * 8192), 16, 0, 0); } while (0)
#define PG8_LDA(dst, b, h) do { _Pragma("unroll") for (int m = 0; m < 4; ++m) _Pragma("unroll") for (int k = 0; k < 2; ++k) dst[m][k] = *(const PG8_LAS bf16x8*)(lds + PG8_SA(b, h) + aoff + m * 2048 + k * 1024); } while (0)
#define PG8_LDB(dst, b, h) do { _Pragma("unroll") for (int n = 0; n < 2; ++n) _Pragma("unroll") for (int k = 0; k < 2; ++k) dst[n][k] = *(const PG8_LAS bf16x8*)(lds + PG8_SB(b, h) + boff + n * 2048 + k * 1024); } while (0)
#define PG8_MMA(ai, bj, At, Bt) do { __builtin_amdgcn_s_setprio(1); _Pragma("unroll") for (int m = 0; m < 4; ++m) _Pragma("unroll") for (int n = 0; n < 2; ++n) _Pragma("unroll") for (int k = 0; k < 2; ++k) \
        acc[ai][bj][m][n] = __builtin_amdgcn_mfma_f32_16x16x32_bf16(Bt[n][k], At[m][k], acc[ai][bj][m][n], 0, 0, 0); __builtin_amdgcn_s_setprio(0); } while (0)
#define PG8_WAIT_V(n) asm volatile("s_waitcnt vmcnt(" #n ")" ::: "memory")
#define PG8_WAIT_L(n) asm volatile("s_waitcnt lgkmcnt(" #n ")" ::: "memory")
#define PG8_BAR __builtin_amdgcn_s_barrier()
#define PG8_SCHED __builtin_amdgcn_sched_barrier(0)
    Unit cur, nxt; int ui = 0;
    if (!S.next(0, cur)) return;
    f32x4 acc[2][2][4][2];
#pragma unroll
    for (int a = 0; a < 2; ++a)
#pragma unroll
        for (int b = 0; b < 2; ++b)
#pragma unroll
            for (int m = 0; m < 4; ++m)
#pragma unroll
                for (int n = 0; n < 2; ++n) acc[a][b][m][n] = (f32x4){0.f, 0.f, 0.f, 0.f};
    bf16x8 At[4][2], B0[2][2], B1[2][2];
    const char* cA = (const char*)(cur.z ? g.A1 : g.A0) + (size_t)cur.pm * tstepA; const char* cB = (const char*)(cur.z ? g.B1 : g.B0) + (size_t)cur.pn * tstepB;
    int nt = (cur.z ? g.K1 : g.K0) / BK;
    PG8_STAGE(PG8_SB(0, 0), cB, voffB); PG8_STAGE(PG8_SB(0, 1), cB + hstepB, voffB); PG8_STAGE(PG8_SA(0, 0), cA, voffA); PG8_STAGE(PG8_SA(0, 1), cA + hstepA, voffA);
    if (wr == 1) PG8_BAR;
    PG8_WAIT_V(2); PG8_BAR;
    PG8_STAGE(PG8_SB(1, 0), cB + kstep, voffB); PG8_STAGE(PG8_SA(1, 0), cA + kstep, voffA); PG8_STAGE(PG8_SB(1, 1), cB + hstepB + kstep, voffB);
    PG8_WAIT_V(6); PG8_BAR;
    for (;;) {
        const bool has_next = S.next(ui + 1, nxt);
        const char* nA = has_next ? (const char*)(nxt.z ? g.A1 : g.A0) + (size_t)nxt.pm * tstepA : cA; const char* nB = has_next ? (const char*)(nxt.z ? g.B1 : g.B0) + (size_t)nxt.pn * tstepB : cB;
#define PG8_W1(t) PG8_WAIT_V(8)
#define PG8_TRIP(t, W1) do { \
            const bool last = ((t) == nt - 2); \
            const char* a1 = cA + (size_t)((t) + 1) * kstep; \
            const char* a2 = last ? nA : cA + (size_t)((t) + 2) * kstep; const char* b2 = last ? nB : cB + (size_t)((t) + 2) * kstep; \
            const char* a3 = a2 + kstep; const char* b3 = b2 + kstep; \
              \
            PG8_LDB(B0, 0, 0); PG8_LDB(B1, 0, 1); PG8_SCHED; PG8_LDA(At, 0, 0); PG8_STAGE(PG8_SA(1, 1), a1 + hstepA, voffA); \
            PG8_W1(t); PG8_WAIT_L(0); PG8_BAR; PG8_MMA(0, 0, At, B0); PG8_MMA(0, 1, At, B1); PG8_BAR; PG8_SCHED; \
              \
            PG8_LDA(At, 0, 1); PG8_STAGE(PG8_SB(0, 0), b2, voffB); PG8_STAGE(PG8_SB(0, 1), b2 + hstepB, voffB); PG8_STAGE(PG8_SA(0, 0), a2, voffA); \
            PG8_W1(t); PG8_WAIT_L(0); PG8_BAR; PG8_MMA(1, 0, At, B0); PG8_MMA(1, 1, At, B1); PG8_BAR; PG8_SCHED; \
              \
            PG8_LDB(B0, 1, 0); PG8_LDB(B1, 1, 1); PG8_SCHED; PG8_LDA(At, 1, 0); PG8_STAGE(PG8_SA(0, 1), a2 + hstepA, voffA); \
            PG8_WAIT_V(8); PG8_WAIT_L(0); PG8_BAR; PG8_MMA(0, 0, At, B0); PG8_MMA(0, 1, At, B1); PG8_BAR; PG8_SCHED; \
              \
            PG8_LDA(At, 1, 1); PG8_STAGE(PG8_SB(1, 0), b3, voffB); PG8_STAGE(PG8_SB(1, 1), b3 + hstepB, voffB); PG8_STAGE(PG8_SA(1, 0), a3, voffA); \
            PG8_WAIT_V(8); PG8_WAIT_L(0); PG8_BAR; PG8_MMA(1, 0, At, B0); PG8_MMA(1, 1, At, B1); PG8_BAR; PG8_SCHED; } while (0)
        for (int t = 0; t < nt; t += 2) PG8_TRIP(t, 8);
        if constexpr (ALIGN_EPI) { if (wr == 0) PG8_BAR; }
        bool keep = false;
        if constexpr (Epi::CHAINZ) { if (cur.z == 0) { E.mid(acc, cur, wr, wc, fr, fq); keep = true; } else E(acc, cur, wr, wc, fr, fq); }
        else E(acc, cur, wr, wc, fr, fq);
        if (!has_next) break;
        if (!keep) {
#pragma unroll
        for (int a = 0; a < 2; ++a)
#pragma unroll
            for (int b = 0; b < 2; ++b)
#pragma unroll
                for (int m = 0; m < 4; ++m)
#pragma unroll
                    for (int n = 0; n < 2; ++n) acc[a][b][m][n] = (f32x4){0.f, 0.f, 0.f, 0.f};
        }
        cur = nxt; cA = nA; cB = nB; ++ui; nt = (cur.z ? g.K1 : g.K0) / BK;
        if constexpr (ALIGN_EPI) { if (wr == 1) PG8_BAR; }
    }
    PG8_WAIT_V(0);
    if constexpr (!ALIGN_EPI) { if (wr == 0) PG8_BAR; }
    PG8_BAR;
#undef PG8_TRIP
#undef PG8_W1
#undef PG8_SA
#undef PG8_SB
#undef PG8_STAGE
#undef PG8_LDA
#undef PG8_LDB
#undef PG8_MMA
#undef PG8_WAIT_V
#undef PG8_WAIT_L
#undef PG8_BAR
#undef PG8_SCHED
}

typedef f32x4 AccT[2][2][4][2];
__device__ __forceinline__ u32x4 pack8(const f32x4 v0, const f32x4 v1) { u32x4 w; w.x = cvt_pk_bf16(v0[0], v0[1]); w.y = cvt_pk_bf16(v0[2], v0[3]); w.z = cvt_pk_bf16(v1[0], v1[1]); w.w = cvt_pk_bf16(v1[2], v1[3]); return w; }
__device__ __forceinline__ void unpack8(const u32x4 w, f32x4& v0, f32x4& v1) {
    v0 = (f32x4){__uint_as_float(w.x << 16), __uint_as_float(w.x & 0xffff0000u), __uint_as_float(w.y << 16), __uint_as_float(w.y & 0xffff0000u)};
    v1 = (f32x4){__uint_as_float(w.z << 16), __uint_as_float(w.z & 0xffff0000u), __uint_as_float(w.w << 16), __uint_as_float(w.w & 0xffff0000u)}; }
__device__ __forceinline__ f32x4 sig4(const f32x4 v) { return (f32x4){sigmoidf_(v[0]), sigmoidf_(v[1]), sigmoidf_(v[2]), sigmoidf_(v[3])}; }
__device__ __forceinline__ float sumsq4(const f32x4 v) { return (v[0] * v[0] + v[1] * v[1]) + (v[2] * v[2] + v[3] * v[3]); }
__device__ __forceinline__ float rstd_from_ss(const float* ss, int row, int fq) {
    const f32x4 a = *(const f32x4*)(ss + (size_t)row * 16 + 4 * fq);
    float s = (a[0] + a[1]) + (a[2] + a[3]);
    s = sum_fq(s);
    return rsqrtf(s * (1.f / D) + EPS); }

struct EpiProj { static constexpr bool PERM = true, CHAINZ = false; bf16* O;
    __device__ __forceinline__ void operator()(const AccT& acc, const Unit& u, int wr, int wc, int fr, int fq) const {
        const int row0 = u.pm * BM + wr * 64 + fr, col0 = u.pn * BM + wc * 32 + 8 * fq;
        const bool iskr = (u.pn >= 14 && u.pn < 16);
        const float base = (u.pn < 4) ? QA_SCALE : (iskr ? KR_SCALE : 1.f);
        const float l2g0 = iskr ? ret_log2gamma(2 * (u.pn - 14)) : 0.f, l2g1 = iskr ? ret_log2gamma(2 * (u.pn - 14) + 1) : 0.f;
        float sc[2][4];
#pragma unroll
        for (int m = 0; m < 4; ++m) { const float e = -(float)(((16 * m + fr) & (RCH - 1)) + 1); sc[0][m] = base * __builtin_amdgcn_exp2f(e * l2g0); sc[1][m] = base * __builtin_amdgcn_exp2f(e * l2g1); }
#pragma unroll
        for (int ai = 0; ai < 2; ++ai)
#pragma unroll
            for (int m = 0; m < 4; ++m) { bf16* rowp = O + (size_t)(row0 + ai * HALF + m * 16) * PP + col0;
#pragma unroll
                for (int bj = 0; bj < 2; ++bj) *(u32x4*)(rowp + bj * HALF) = pack8(acc[ai][bj][m][0] * sc[bj][m], acc[ai][bj][m][1] * sc[bj][m]); }
    }
};
struct EpiGate { static constexpr bool PERM = true, CHAINZ = false; bf16* O;
    __device__ __forceinline__ void operator()(const AccT& acc, const Unit& u, int wr, int wc, int fr, int fq) const {
        const int row0 = u.pm * BM + wr * 64 + fr, col0 = u.pn * BM + wc * 32 + 8 * fq;
#pragma unroll
        for (int ai = 0; ai < 2; ++ai)
#pragma unroll
            for (int m = 0; m < 4; ++m) { bf16* rowp = O + (size_t)(row0 + ai * HALF + m * 16) * PP + col0;
#pragma unroll
                for (int bj = 0; bj < 2; ++bj) *(u32x4*)(rowp + bj * HALF) = pack8(acc[ai][bj][m][0], acc[ai][bj][m][1]); }
    }
};
struct EpiMix { static constexpr bool PERM = true, CHAINZ = true; const bf16* proj; bf16* mix;
    __device__ __forceinline__ void mid(AccT& acc, const Unit& u, int wr, int wc, int fr, int fq) const {
        const int row0 = u.pm * BM + wr * 64 + fr, col0 = u.pn * BM + wc * 32 + 8 * fq;
#pragma unroll
        for (int ai = 0; ai < 2; ++ai)
#pragma unroll
            for (int m = 0; m < 4; ++m) { const size_t r = (size_t)(row0 + ai * HALF + m * 16);
#pragma unroll
                for (int bj = 0; bj < 2; ++bj) { const int c = col0 + bj * HALF;
                    f32x4 a0, a1, b0, b1; unpack8(*(const u32x4*)(proj + r * PP + O_GA + c), a0, a1); unpack8(*(const u32x4*)(proj + r * PP + O_GB + c), b0, b1);
#pragma unroll
                    for (int e = 0; e < 4; ++e) {
                        acc[ai][bj][m][0][e] *= (1.f + __builtin_amdgcn_exp2f(-b0[e] * LOG2E)) * __builtin_amdgcn_rcpf(1.f + __builtin_amdgcn_exp2f(-a0[e] * LOG2E));
                        acc[ai][bj][m][1][e] *= (1.f + __builtin_amdgcn_exp2f(-b1[e] * LOG2E)) * __builtin_amdgcn_rcpf(1.f + __builtin_amdgcn_exp2f(-a1[e] * LOG2E)); } } }
    }
    __device__ __forceinline__ void operator()(const AccT& acc, const Unit& u, int wr, int wc, int fr, int fq) const {
        const int row0 = u.pm * BM + wr * 64 + fr, col0 = u.pn * BM + wc * 32 + 8 * fq;
#pragma unroll
        for (int ai = 0; ai < 2; ++ai)
#pragma unroll
            for (int m = 0; m < 4; ++m) { const size_t r = (size_t)(row0 + ai * HALF + m * 16);
#pragma unroll
                for (int bj = 0; bj < 2; ++bj) { const int c = col0 + bj * HALF;
                    f32x4 g0, g1; unpack8(*(const u32x4*)(proj + r * PP + O_GB + c), g0, g1);
                    *(u32x4*)(mix + r * D + c) = pack8(sig4(g0) * acc[ai][bj][m][0], sig4(g1) * acc[ai][bj][m][1]); } }
    }
};
template <bool IN_BF16> struct EpiRes { static constexpr bool PERM = true, CHAINZ = false; const float* xin; bf16* xb; float* ss;
    __device__ __forceinline__ void operator()(const AccT& acc, const Unit& u, int wr, int wc, int fr, int fq) const {
        const int row0 = u.pm * BM + wr * 64 + fr, col0 = u.pn * BM + wc * 32 + 8 * fq;
#pragma unroll
        for (int ai = 0; ai < 2; ++ai)
#pragma unroll
            for (int m = 0; m < 4; ++m) { const size_t r = (size_t)(row0 + ai * HALF + m * 16); float q = 0.f;
#pragma unroll
                for (int bj = 0; bj < 2; ++bj) { const size_t o = r * D + col0 + bj * HALF;
                    f32x4 x0, x1;
                    if (IN_BF16) unpack8(*(const u32x4*)(xb + o), x0, x1); else { x0 = *(const f32x4*)(xin + o); x1 = *(const f32x4*)(xin + o + 4); }
                    const f32x4 v0 = x0 + acc[ai][bj][m][0], v1 = x1 + acc[ai][bj][m][1];
                    *(u32x4*)(xb + o) = pack8(v0, v1);
                    q += sumsq4(v0) + sumsq4(v1); }
                q = sum_fq(q);
                if (fq == 0) ss[r * 16 + u.pn * 4 + wc] = q; }
    }
};
struct EpiHid { static constexpr bool PERM = true, CHAINZ = false; const float* ss; bf16* hid;
    __device__ __forceinline__ void operator()(const AccT& acc, const Unit& u, int wr, int wc, int fr, int fq) const {
        const int row0 = u.pm * BM + wr * 64 + fr, col0 = u.pn * BM + wc * 32 + 8 * fq;
#pragma unroll
        for (int ai = 0; ai < 2; ++ai)
#pragma unroll
            for (int m = 0; m < 4; ++m) { const int r = row0 + ai * HALF + m * 16; const float rstd = rstd_from_ss(ss, r, fq);
#pragma unroll
                for (int bj = 0; bj < 2; ++bj) { f32x4 v0 = acc[ai][bj][m][0] * rstd, v1 = acc[ai][bj][m][1] * rstd;
#pragma unroll
                    for (int e = 0; e < 4; ++e) { v0[e] = fmaxf(v0[e], 0.f); v1[e] = fmaxf(v1[e], 0.f); }
                    *(u32x4*)(hid + (size_t)r * FF + col0 + bj * HALF) = pack8(v0 * v0, v1 * v1); } }
    }
};
struct EpiPle { static constexpr bool PERM = true, CHAINZ = false; const float* ss2; bf16* part; const bf16* x2b; float* ss3;
    __device__ __forceinline__ void operator()(const AccT& acc, const Unit& u, int wr, int wc, int fr, int fq) const {
        const int row0 = u.pm * BM + wr * 64 + fr, col0 = u.pn * BM + wc * 32 + 8 * fq;
#pragma unroll
        for (int ai = 0; ai < 2; ++ai)
#pragma unroll
            for (int m = 0; m < 4; ++m) { const size_t r = (size_t)(row0 + ai * HALF + m * 16); float q = 0.f;
                const float rstd = u.z ? rstd_from_ss(ss2, (int)r, fq) : 1.f;
#pragma unroll
                for (int bj = 0; bj < 2; ++bj) { const size_t o = r * D + col0 + bj * HALF;
                    if (u.z == 0) { *(u32x4*)(part + o) = pack8(acc[ai][bj][m][0], acc[ai][bj][m][1]); }
                    else { f32x4 p0, p1, x0, x1; unpack8(*(const u32x4*)(part + o), p0, p1); unpack8(*(const u32x4*)(x2b + o), x0, x1);
                        const f32x4 v0 = x0 + sig4(acc[ai][bj][m][0] * rstd) * p0, v1 = x1 + sig4(acc[ai][bj][m][1] * rstd) * p1;
                        *(u32x4*)(part + o) = pack8(v0, v1); q += sumsq4(v0) + sumsq4(v1); } }
                if (u.z) { q = sum_fq(q); if (fq == 0) ss3[r * 16 + u.pn * 4 + wc] = q; } }
    }
};
}

namespace att {
typedef short bf16x8 __attribute__((ext_vector_type(8)));
typedef short s16x4 __attribute__((ext_vector_type(4)));
typedef float f32x16 __attribute__((ext_vector_type(16)));
constexpr int SHM_V = 16384, SHM_K = 16384;
constexpr int NBUF = 4, A_V = 0, A_K = NBUF * SHM_V, A_WS = A_K + NBUF * SHM_K, A_X = 0  , XPITCH = 132, X_BYTES = 17408, A_END = A_WS + 2048;
static_assert(4 * X_BYTES <= A_WS, "exchange region inside the tile buffers");
constexpr int A_G = 145408;
constexpr float THR = 8.f;
#define ATT_KSWZ(row, colB) ((row) * 256 + ((colB) ^ (((row) & 7) << 4)))
#define ATT_SBAR() __builtin_amdgcn_sched_barrier(0)
__device__ __forceinline__ int crow(int r, int hi) { return (r & 3) + 8 * (r >> 2) + 4 * hi; }
__device__ __forceinline__ unsigned cvtpk(float lo, float hi) { unsigned r; asm volatile("v_cvt_pk_bf16_f32 %0, %1, %2" : "=v"(r) : "v"(lo), "v"(hi)); return r; }
__device__ __forceinline__ int v_st(int k, int c) { const int kk = (k & ~0xC) | ((k & 4) << 1) | ((k & 8) >> 1); return ((kk >> 3) * 4 + (c >> 5)) * 512 + ((kk & 7) * 32 + (c & 31)) * 2; }
__device__ __forceinline__ int v_rd_base(int lane) { return ((lane & 3) << 3) | (((lane >> 2) & 3) << 6) | (((lane >> 4) & 1) << 5) | (((lane >> 5) & 1) << 8); }
constexpr int v_rd_off(int d0, int ks, int half) { return d0 * 512 + ks * 4096 + half * 2048; }
typedef short v4i16_t __attribute__((ext_vector_type(4)));
__device__ __forceinline__ s16x4 vtr(const LAS unsigned char* p) { return __builtin_bit_cast(s16x4, __builtin_amdgcn_ds_read_tr16_b64_v4i16((LAS v4i16_t*)p)); }
#define ATT_PK(L, H) (bf16x8){L[0], L[1], L[2], L[3], H[0], H[1], H[2], H[3]}
struct VFrag { s16x4 l0, h0, l1, h1, l2, h2, l3, h3; };
template <int D0> __device__ __forceinline__ void vload(VFrag& f, const LAS unsigned char* vp) {
  f.l0 = vtr(vp + v_rd_off(D0, 0, 0)); f.h0 = vtr(vp + v_rd_off(D0, 0, 1)); f.l1 = vtr(vp + v_rd_off(D0, 1, 0)); f.h1 = vtr(vp + v_rd_off(D0, 1, 1));
  f.l2 = vtr(vp + v_rd_off(D0, 2, 0)); f.h2 = vtr(vp + v_rd_off(D0, 2, 1)); f.l3 = vtr(vp + v_rd_off(D0, 3, 0)); f.h3 = vtr(vp + v_rd_off(D0, 3, 1));
}
__device__ __forceinline__ void pv_mma(f32x16& od, const VFrag& f, bf16x8 pa0, bf16x8 pa1, bf16x8 pa2, bf16x8 pa3) {
  od = __builtin_amdgcn_mfma_f32_32x32x16_bf16(pa0, ATT_PK(f.l0, f.h0), od, 0, 0, 0);
  od = __builtin_amdgcn_mfma_f32_32x32x16_bf16(pa1, ATT_PK(f.l1, f.h1), od, 0, 0, 0);
  od = __builtin_amdgcn_mfma_f32_32x32x16_bf16(pa2, ATT_PK(f.l2, f.h2), od, 0, 0, 0);
  od = __builtin_amdgcn_mfma_f32_32x32x16_bf16(pa3, ATT_PK(f.l3, f.h3), od, 0, 0, 0);
}
struct KFrag { bf16x8 a[2], b[2]; };
template <int H> __device__ __forceinline__ void kload(KFrag& k, const LAS unsigned char* Ks, int c, int r32, int hi) {
#pragma unroll
  for (int d = 0; d < 2; ++d) { const int cb = (c * 64 + (2 * H + d) * 16 + hi * 8) * 2;
    k.a[d] = *(const LAS bf16x8*)(Ks + ATT_KSWZ(r32, cb)); k.b[d] = *(const LAS bf16x8*)(Ks + ATT_KSWZ(32 + r32, cb)); }
}
template <bool DOPV> __device__ __forceinline__ void mma_stage(f32x16* o, f32x16& p0, f32x16& p1, const LAS unsigned char* vp, const LAS unsigned char* Ks, bf16x8 pa0, bf16x8 pa1, bf16x8 pa2, bf16x8 pa3,
                                                              const bf16x8* qr, bf16x8 kx0, bf16x8 kx1, bf16x8 qx, int c, int r32, int hi, const VFrag& f0, const KFrag& k0) {
  KFrag k1;
  if (DOPV) {
    VFrag fa = f0, fb;
    vload<1>(fb, vp); ATT_SBAR(); pv_mma(o[0], fa, pa0, pa1, pa2, pa3); ATT_SBAR();
    vload<2>(fa, vp); ATT_SBAR(); pv_mma(o[1], fb, pa0, pa1, pa2, pa3); ATT_SBAR();
    vload<3>(fb, vp); ATT_SBAR(); pv_mma(o[2], fa, pa0, pa1, pa2, pa3); ATT_SBAR();
    kload<1>(k1, Ks, c, r32, hi); ATT_SBAR(); pv_mma(o[3], fb, pa0, pa1, pa2, pa3); ATT_SBAR();
  } else kload<1>(k1, Ks, c, r32, hi);
  p0 = __builtin_amdgcn_mfma_f32_32x32x16_bf16(kx0, qx, f32x16{}, 0, 0, 0); p1 = __builtin_amdgcn_mfma_f32_32x32x16_bf16(kx1, qx, f32x16{}, 0, 0, 0);
#pragma unroll
  for (int d = 0; d < 2; ++d) { p0 = __builtin_amdgcn_mfma_f32_32x32x16_bf16(k0.a[d], qr[d], p0, 0, 0, 0); p1 = __builtin_amdgcn_mfma_f32_32x32x16_bf16(k0.b[d], qr[d], p1, 0, 0, 0); }
#pragma unroll
  for (int d = 0; d < 2; ++d) { p0 = __builtin_amdgcn_mfma_f32_32x32x16_bf16(k1.a[d], qr[2 + d], p0, 0, 0, 0); p1 = __builtin_amdgcn_mfma_f32_32x32x16_bf16(k1.b[d], qr[2 + d], p1, 0, 0, 0); }
}
__device__ __forceinline__ void pv_d0(f32x16* o, const LAS unsigned char* vp, bf16x8 pa0, bf16x8 pa1, bf16x8 pa2, bf16x8 pa3, const VFrag& f0) {
  VFrag fa = f0, fb;
  vload<1>(fb, vp); ATT_SBAR(); pv_mma(o[0], fa, pa0, pa1, pa2, pa3); ATT_SBAR();
  vload<2>(fa, vp); ATT_SBAR(); pv_mma(o[1], fb, pa0, pa1, pa2, pa3); ATT_SBAR();
  vload<3>(fb, vp); ATT_SBAR(); pv_mma(o[2], fa, pa0, pa1, pa2, pa3); ATT_SBAR();
  pv_mma(o[3], fb, pa0, pa1, pa2, pa3);
}
__device__ __forceinline__ float vmax3(float a, float b, float c) { float r; asm("v_max3_f32 %0, %1, %2, %3" : "=v"(r) : "v"(a), "v"(b), "v"(c)); return r; }
__device__ __forceinline__ float vmax2(float a, float b) { float r; asm("v_max_f32 %0, %1, %2" : "=v"(r) : "v"(a), "v"(b)); return r; }
template <bool MASK> __device__ __forceinline__ bool softmax_stage(f32x16& p0, f32x16& p1, float& m_ref, float& l_reg, f32x16* o, bf16x8& pa0, bf16x8& pa1, bf16x8& pa2, bf16x8& pa3,
                                                                  int qrel, int hi, int r32, LAS float* al_l) {
  if (MASK) {
    int qa = qrel - 4 * hi; asm volatile("" : "+v"(qa));
#pragma unroll
    for (int r = 0; r < 16; ++r) { const int cr = (r & 3) + 8 * (r >> 2); p0[r] = (cr > qa) ? -INFINITY : p0[r]; p1[r] = (cr + 32 > qa) ? -INFINITY : p1[r]; }
  }
  float pmax, pmb;
  pmax = vmax3(p0[0], p0[1], p0[2]); pmb = vmax3(p1[0], p1[1], p1[2]);
#pragma unroll
  for (int k = 0; k < 6; ++k) { pmax = vmax3(pmax, p0[3 + 2 * k], p0[4 + 2 * k]); pmb = vmax3(pmb, p1[3 + 2 * k], p1[4 + 2 * k]); }
  pmax = vmax3(pmax, p0[15], p1[15]);
  { const float m2 = vmax2(pmax, pmb); auto rr = __builtin_amdgcn_permlane32_swap(__float_as_uint(m2), __float_as_uint(m2), false, false); pmax = vmax2(__uint_as_float(rr[0]), __uint_as_float(rr[1])); }
  if (__all(pmax < -140.f)) return false;
  float alpha = 1.f;
  if (__builtin_expect(!__all(pmax <= THR), 0)) {
    const float dl = fmaxf(pmax, 0.f); alpha = __builtin_amdgcn_exp2f(-dl); m_ref += dl;
#pragma unroll
    for (int r = 0; r < 16; ++r) { p0[r] -= dl; p1[r] -= dl; }
    if (hi == 0) al_l[r32] = alpha; asm volatile("s_waitcnt lgkmcnt(0)" ::: "memory");
#pragma unroll
    for (int d = 0; d < 4; ++d)
#pragma unroll
      for (int r = 0; r < 16; ++r) o[d][r] *= al_l[crow(r, hi)];
  }
#pragma unroll
  for (int r = 0; r < 16; ++r) { p0[r] = __builtin_amdgcn_exp2f(p0[r]); p1[r] = __builtin_amdgcn_exp2f(p1[r]); }
  float ps = p0[0] + p1[0];
#pragma unroll
  for (int r = 1; r < 16; ++r) { ps += p0[r]; ps += p1[r]; }
  { auto rr = __builtin_amdgcn_permlane32_swap(__float_as_uint(ps), __float_as_uint(ps), false, false); ps = __uint_as_float(rr[0]) + __uint_as_float(rr[1]); }
  l_reg = l_reg * alpha + ps;
#define ATT_PK4(P, BASE, OUT) do { unsigned a0 = cvtpk(P[BASE + 0], P[BASE + 1]), a1 = cvtpk(P[BASE + 2], P[BASE + 3]);   \
    unsigned b0 = cvtpk(P[BASE + 4], P[BASE + 5]), b1 = cvtpk(P[BASE + 6], P[BASE + 7]);                              \
    auto r0 = __builtin_amdgcn_permlane32_swap(a0, b0, false, false); auto r1 = __builtin_amdgcn_permlane32_swap(a1, b1, false, false); \
    u32x4 w = {r0[0], r1[0], r0[1], r1[1]}; OUT = __builtin_bit_cast(bf16x8, w); } while (0)
  ATT_PK4(p0, 0, pa0); ATT_PK4(p0, 8, pa1); ATT_PK4(p1, 0, pa2); ATT_PK4(p1, 8, pa3);
#undef ATT_PK4
  return true;
}

__device__ __forceinline__ void attn_unit(LAS unsigned char* lds, const bf16* __restrict__ proj, bf16* __restrict__ ya, int b, int h, int qb, float lam, const float* __restrict__ gdiff) {
  int tid_ = threadIdx.x; asm volatile("" : "+v"(tid_));
  const int tid = tid_, wid = __builtin_amdgcn_readfirstlane(tid >> 6), lane = tid & 63, r32 = lane & 31, hi = lane >> 5, c = wid >> 2, rg = wid & 3;
  const int q0 = qb * 128, NT = 2 * (qb + 1), qloc = rg * 32 + r32;
  const size_t rowbase = (size_t)b * S;
  const bf16* Kh = proj + rowbase * PP + O_KA + h * 128; const bf16* Vh = proj + rowbase * PP + O_VA + h * 128;
  const bf16* Qw = proj + (rowbase + q0 + qloc) * PP + O_QA + h * 128 + c * 64 + hi * 8;
  LAS unsigned char* V_lds = lds + A_V; LAS unsigned char* K_lds = lds + A_K;
  LAS float* wsf = (LAS float*)(lds + A_WS) + wid * 64; LAS float* li_l = wsf; LAS float* al_l = wsf + 32;
  float l_reg = 0; f32x16 o[4] = {}; bf16x8 qr[4];
#pragma unroll
  for (int d0 = 0; d0 < 4; ++d0) qr[d0] = *(const bf16x8*)(Qw + d0 * 16);
  const LAS unsigned char* vp0 = V_lds + v_rd_base(lane);
  const float slope2 = __builtin_amdgcn_exp2f(-(float)(h + 1)) * LOG2E;
  bf16x8 kx0 = bf16x8{}, kx1 = bf16x8{}; unsigned qxw0 = 0u;
  { const unsigned shi = __float_as_uint(slope2) & 0xffff0000u; const float slo = slope2 - __uint_as_float(shi);
    const unsigned k0 = __float_as_uint((float)r32) >> 16, k1 = __float_as_uint((float)(32 + r32)) >> 16;
    if (hi == 0) { u32x4 w = {k0 | (k0 << 16), 0x3f803f80u, 0x00003f80u, 0u}; kx0 = __builtin_bit_cast(bf16x8, w); w.x = k1 | (k1 << 16); kx1 = __builtin_bit_cast(bf16x8, w);
                   qxw0 = (shi >> 16) | ((unsigned)f2bf(slo) << 16); } }
  const unsigned himask = hi ? 0u : 0xffffffffu;
  unsigned kso[2], vso[2];
#pragma unroll
  for (int j = 0; j < 2; ++j) { const int pc = wid * 2 + j;
    { const int row = 4 * pc + (lane >> 4), ch = (lane & 15) ^ (row & 7); kso[j] = (unsigned)(row * PP + ch * 8); }
    { const int st = 2 * pc + (lane >> 5), i5 = lane & 31, kk = (st >> 2) * 8 + (i5 >> 2), k = (kk & ~0xC) | ((kk & 4) << 1) | ((kk & 8) >> 1), cc = (st & 3) * 32 + (i5 & 3) * 8;
      vso[j] = (unsigned)(k * PP + cc); } }
#define ATT_DMA16(gp, la) asm volatile("s_mov_b32 m0, %1\n\ts_nop 0\n\tglobal_load_lds_dwordx4 %0, off" :: "v"(gp), "s"(la) : "memory", "m0")
#define ATT_DMAK(t, bf) do { _Pragma("unroll") for (int j_ = 0; j_ < 2; ++j_) ATT_DMA16(Kh + (size_t)(64 * (t)) * PP + kso[j_], (unsigned)(size_t)(K_lds + (bf) * SHM_K + (wid * 2 + j_) * 1024)); } while (0)
#define ATT_DMAV(t, bf) do { _Pragma("unroll") for (int j_ = 0; j_ < 2; ++j_) ATT_DMA16(Vh + (size_t)(64 * (t)) * PP + vso[j_], (unsigned)(size_t)(V_lds + (bf) * SHM_V + (wid * 2 + j_) * 1024)); } while (0)
#define ATT_BAR() do { asm volatile("" ::: "memory"); __builtin_amdgcn_s_waitcnt(0xC07F); __builtin_amdgcn_s_barrier(); asm volatile("" ::: "memory"); } while (0)
#define ATT_BARV() do { asm volatile("" ::: "memory"); __builtin_amdgcn_s_waitcnt(0x0070); __builtin_amdgcn_s_barrier(); asm volatile("" ::: "memory"); } while (0)
  f32x16 p0, p1; bf16x8 pa0 = bf16x8{}, pa1 = bf16x8{}, pa2 = bf16x8{}, pa3 = bf16x8{}; bool dopv = false;
#define ATT_ITER(MASK, i_) do { const int i = (i_), t = NT - 1 - i; \
    bf16x8 qx; { const float v_ = slope2 * (float)(64 * t - (q0 + 127)) - m_ref; const unsigned v1_ = __float_as_uint(v_) & 0xffff0000u; const float r1_ = v_ - __uint_as_float(v1_); \
      const unsigned v2_ = __float_as_uint(r1_) & 0xffff0000u; const float r2_ = r1_ - __uint_as_float(v2_); \
      const u32x4 w_ = {qxw0, ((v1_ >> 16) | v2_) & himask, (unsigned)f2bf(r2_) & himask, 0u}; qx = __builtin_bit_cast(bf16x8, w_); } \
    __builtin_amdgcn_s_setprio(2); \
    if (dopv) mma_stage<true>(o, p0, p1, vp0 + ((i - 1) & 3) * SHM_V, K_lds + (i & 3) * SHM_K, pa0, pa1, pa2, pa3, qr, kx0, kx1, qx, c, r32, hi, vf0, kf0); \
    else mma_stage<false>(o, p0, p1, vp0 + ((i - 1) & 3) * SHM_V, K_lds + (i & 3) * SHM_K, pa0, pa1, pa2, pa3, qr, kx0, kx1, qx, c, r32, hi, vf0, kf0); \
    __builtin_amdgcn_s_setprio(0); \
    ATT_BAR(); \
      \
    asm volatile("s_nop 15" : "+v"(p0), "+v"(p1)); \
    dopv = softmax_stage<MASK>(p0, p1, m_ref, l_reg, o, pa0, pa1, pa2, pa3, q0 + qloc - 64 * t, hi, r32, al_l); \
      \
    vload<0>(vf0, vp0 + (i & 3) * SHM_V); kload<0>(kf0, K_lds + ((i + 1) & 3) * SHM_K, c, r32, hi); \
    asm volatile("" ::: "memory"); __builtin_amdgcn_s_waitcnt(0x0F70);     \
      \
    if (i + 2 < NT) { ATT_DMAV(t - 2, (i + 2) & 3); if (i + 3 < NT) ATT_DMAK(t - 3, (i + 3) & 3); } \
    ATT_BAR(); } while (0)
  VFrag vf0; KFrag kf0;
  float m_ref = slope2 * (float)(64 * (NT - 1) - (q0 + 127));
  ATT_DMAK(NT - 1, 0); ATT_DMAV(NT - 1, 0); ATT_DMAK(NT - 2, 1);
  ATT_DMAV(NT - 2, 1);
  asm volatile("" ::: "memory");
  if (NT > 2) { ATT_DMAK(NT - 3, 2); __builtin_amdgcn_s_waitcnt(0x0F74); } else __builtin_amdgcn_s_waitcnt(0x0F72);
  ATT_BAR();
  kload<0>(kf0, K_lds, c, r32, hi); vload<0>(vf0, vp0);
  if (c == 1) ATT_BAR();
  ATT_ITER(true, 0); ATT_ITER(true, 1);
  for (int it = 2; it < NT; ++it) ATT_ITER(false, it);
  if (dopv) pv_d0(o, vp0 + ((NT - 1) & 3) * SHM_V, pa0, pa1, pa2, pa3, vf0);
  if (c == 0) ATT_BAR();
#undef ATT_ITER
  ATT_BAR();
  if (hi == 0) li_l[r32] = l_reg; asm volatile("s_waitcnt lgkmcnt(0)" ::: "memory");
  float rli[16];
#pragma unroll
  for (int r = 0; r < 16; ++r) rli[r] = __builtin_amdgcn_rcpf(li_l[crow(r, hi)]);
  LAS float* X = (LAS float*)(lds + A_X + rg * X_BYTES);
  if (c == 1) {
#pragma unroll
    for (int d0 = 0; d0 < 4; ++d0)
#pragma unroll
      for (int r = 0; r < 16; ++r) X[(d0 * 16 + r) * 64 + lane] = o[d0][r] * rli[r];
  }
  ATT_BAR();
  if (c == 0) {
#pragma unroll
    for (int d0 = 0; d0 < 4; ++d0)
#pragma unroll
      for (int r = 0; r < 16; ++r) o[d0][r] = o[d0][r] * rli[r] - lam * X[(d0 * 16 + r) * 64 + lane];
    asm volatile("s_waitcnt lgkmcnt(0)" ::: "memory"); __builtin_amdgcn_wave_barrier();
#pragma unroll
    for (int d0 = 0; d0 < 4; ++d0)
#pragma unroll
      for (int r = 0; r < 16; ++r) X[crow(r, hi) * XPITCH + d0 * 32 + r32] = o[d0][r];
    asm volatile("s_waitcnt lgkmcnt(0)" ::: "memory"); __builtin_amdgcn_wave_barrier();
    const int row = lane >> 1, half = lane & 1;
    const LAS f32x4* yr = (const LAS f32x4*)(X + row * XPITCH + half * 64);
    f32x4 yv[16]; float ssq = 0.f;
#pragma unroll
    for (int i = 0; i < 16; ++i) { yv[i] = yr[i]; ssq += (yv[i][0] * yv[i][0] + yv[i][1] * yv[i][1]) + (yv[i][2] * yv[i][2] + yv[i][3] * yv[i][3]); }
    ssq += __shfl_xor(ssq, 1);
    const float sc_ = rsqrtf(ssq * (1.f / 128.f) + EPS); const LAS f32x4* Gl = (const LAS f32x4*)(lds + A_G) + half * 16;
    bf16* orow = ya + (rowbase + q0 + rg * 32 + row) * PP + h * 128 + half * 64;
#pragma unroll
    for (int i = 0; i < 8; ++i) { const f32x4 g0 = Gl[2 * i], g1 = Gl[2 * i + 1];
      u32x4 w; w.x = cvtpk(yv[2 * i][0] * sc_ * g0[0], yv[2 * i][1] * sc_ * g0[1]); w.y = cvtpk(yv[2 * i][2] * sc_ * g0[2], yv[2 * i][3] * sc_ * g0[3]);
      w.z = cvtpk(yv[2 * i + 1][0] * sc_ * g1[0], yv[2 * i + 1][1] * sc_ * g1[1]); w.w = cvtpk(yv[2 * i + 1][2] * sc_ * g1[2], yv[2 * i + 1][3] * sc_ * g1[3]);
      *(u32x4*)(orow + 8 * i) = w; }
  }
  ATT_BAR();
#undef ATT_DMAK
#undef ATT_DMAV
#undef ATT_BAR
#undef ATT_BARV
}
}


namespace ret {
using att::bf16x8; using att::s16x4; using att::f32x16; using att::crow; using att::cvtpk;
constexpr int QP = 272, KP = 320, VP = 576, OP = 260;
constexpr int SZ_Q = 32 * QP, SZ_K = 32 * KP, SZ_V = 32 * VP, SZ_BUF = SZ_Q + SZ_K + SZ_V, R_OUT = 2 * SZ_BUF, R_END = R_OUT + 32 * OP * 4;
static_assert(SZ_BUF % 16 == 0 && R_OUT % 16 == 0, "LDS alignment");
__device__ __forceinline__ s16x4 trr(int addr) { s16x4 r; asm volatile("ds_read_b64_tr_b16 %0, %1" : "=&v"(r) : "v"(addr) : "memory"); return r; }
#define RET_PK(L, H) (bf16x8){L[0], L[1], L[2], L[3], H[0], H[1], H[2], H[3]}
#define RET_PK4(P, BASE, OUT) do { unsigned a0 = cvtpk(P[BASE + 0], P[BASE + 1]), a1 = cvtpk(P[BASE + 2], P[BASE + 3]);   \
    unsigned b0 = cvtpk(P[BASE + 4], P[BASE + 5]), b1 = cvtpk(P[BASE + 6], P[BASE + 7]);                              \
    auto r0 = __builtin_amdgcn_permlane32_swap(a0, b0, false, false); auto r1 = __builtin_amdgcn_permlane32_swap(a1, b1, false, false); \
    u32x4 w_ = {r0[0], r1[0], r0[1], r1[1]}; OUT = __builtin_bit_cast(bf16x8, w_); } while (0)
__device__ __forceinline__ void ret_chain(LAS unsigned char* lds, const bf16* __restrict__ proj, bf16* __restrict__ yr, int b, int h, const float* __restrict__ gret) {
  int tid_ = threadIdx.x; asm volatile("" : "+v"(tid_));
  const int tid = tid_, w = __builtin_amdgcn_readfirstlane(tid >> 6), lane = tid & 63, r32 = lane & 31, hi = lane >> 5, g16 = (lane >> 4) & 1, i16 = lane & 15, q4 = i16 >> 2, p4 = i16 & 3;
  const size_t rowbase = (size_t)b * S;
  const float l2g = ret_log2gamma(h), gC = __builtin_amdgcn_exp2f(l2g * (float)RCH);
  const int srow = tid >> 4, sch = tid & 15;
  const bf16* qsrc = proj + (rowbase + srow) * PP + O_QR + h * 128 + sch * 8;
  const bf16* ksrc = proj + (rowbase + srow) * PP + O_KR + h * 128 + sch * 8;
  const bf16* vsrc = proj + (rowbase + srow) * PP + O_VR + h * 256 + sch * 8;
  const int qdst = srow * QP + sch * 16, kdst = SZ_Q + srow * KP + sch * 16, vdst = SZ_Q + SZ_K + srow * VP + sch * 16;
  const int ldsb = (int)(unsigned)(uintptr_t)lds;
  const int qrd = r32 * QP + hi * 16, krd = SZ_Q + r32 * KP + hi * 16;
  const int ktr = ldsb + SZ_Q + (8 * hi + q4) * KP + (16 * g16 + 4 * p4) * 2;
  const int vtr = ldsb + SZ_Q + SZ_K + (8 * hi + q4) * VP + (32 * w + 16 * g16 + 4 * p4) * 2;
  const int erow = tid >> 4, ec0 = (tid & 15) * 16;
  struct { bf16x8 q, k, v0, v1; } st;
#define RET_LOADS(i) do { const size_t ro_ = (size_t)(i) * RCH * PP; st.q = *(const bf16x8*)(qsrc + ro_); st.k = *(const bf16x8*)(ksrc + ro_); st.v0 = *(const bf16x8*)(vsrc + ro_); st.v1 = *(const bf16x8*)(vsrc + ro_ + 128); } while (0)
#define RET_WRITE(bf) do { LAS unsigned char* d_ = lds + (bf) * SZ_BUF; *(LAS bf16x8*)(d_ + qdst) = st.q; *(LAS bf16x8*)(d_ + kdst) = st.k; *(LAS bf16x8*)(d_ + vdst) = st.v0; *(LAS bf16x8*)(d_ + vdst + 256) = st.v1; } while (0)
  f32x16 R[4];
#pragma unroll
  for (int kb = 0; kb < 4; ++kb) R[kb] = f32x16{};
  float qd[16];
#pragma unroll
  for (int r = 0; r < 16; ++r) qd[r] = __builtin_amdgcn_exp2f(l2g * (float)(crow(r, hi) + 1));
  RET_LOADS(0); asm volatile("s_waitcnt vmcnt(0)" ::: "memory"); RET_WRITE(0); RET_LOADS(1);
  constexpr int NCH = S / RCH;
  for (int i = 0; i < NCH; ++i) {
    const int bf = i & 1;
    asm volatile("s_waitcnt lgkmcnt(0)\n\ts_barrier" ::: "memory");
    if (i + 1 < NCH) { RET_WRITE(bf ^ 1); if (i + 2 < NCH) RET_LOADS(i + 2); }
    const size_t erow_g = rowbase + (size_t)i * RCH + erow;
    const u32x4 gr0 = *(const u32x4*)(proj + erow_g * PP + O_GR + h * 256 + ec0), gr1 = *(const u32x4*)(proj + erow_g * PP + O_GR + h * 256 + ec0 + 8);
    const LAS unsigned char* B_ = lds + bf * SZ_BUF; const int boff = bf * SZ_BUF;
    bf16x8 qf[8]; f32x16 x = f32x16{};
#pragma unroll
    for (int s_ = 0; s_ < 8; ++s_) qf[s_] = *(const LAS bf16x8*)(B_ + qrd + 32 * s_);
#pragma unroll
    for (int s_ = 0; s_ < 8; ++s_) { const bf16x8 kf = *(const LAS bf16x8*)(B_ + krd + 32 * s_); x = __builtin_amdgcn_mfma_f32_32x32x16_bf16(kf, qf[s_], x, 0, 0, 0); }
#pragma unroll
    for (int r = 0; r < 16; ++r) x[r] = (crow(r, hi) <= r32) ? x[r] : 0.f;
    bf16x8 xa0, xa1; RET_PK4(x, 0, xa0); RET_PK4(x, 8, xa1);
    bf16x8 vf0, vf1;
    { const s16x4 l0 = trr(vtr + boff), h0 = trr(vtr + boff + 4 * VP), l1 = trr(vtr + boff + 16 * VP), h1 = trr(vtr + boff + 20 * VP);
      asm volatile("s_waitcnt lgkmcnt(0)" ::: "memory"); __builtin_amdgcn_sched_barrier(0); vf0 = RET_PK(l0, h0); vf1 = RET_PK(l1, h1); }
    f32x16 o = __builtin_amdgcn_mfma_f32_32x32x16_bf16(xa0, vf0, f32x16{}, 0, 0, 0); o = __builtin_amdgcn_mfma_f32_32x32x16_bf16(xa1, vf1, o, 0, 0, 0);
#pragma unroll
    for (int kb = 0; kb < 4; ++kb) { bf16x8 rb0, rb1; RET_PK4(R[kb], 0, rb0); RET_PK4(R[kb], 8, rb1);
      o = __builtin_amdgcn_mfma_f32_32x32x16_bf16(qf[2 * kb], rb0, o, 0, 0, 0); o = __builtin_amdgcn_mfma_f32_32x32x16_bf16(qf[2 * kb + 1], rb1, o, 0, 0, 0); }
#pragma unroll
    for (int kb = 0; kb < 4; ++kb) {
      const s16x4 l0 = trr(ktr + boff + 64 * kb), h0 = trr(ktr + boff + 64 * kb + 4 * KP), l1 = trr(ktr + boff + 64 * kb + 16 * KP), h1 = trr(ktr + boff + 64 * kb + 20 * KP);
      asm volatile("s_waitcnt lgkmcnt(0)" ::: "memory"); __builtin_amdgcn_sched_barrier(0);
      R[kb] = __builtin_amdgcn_mfma_f32_32x32x16_bf16(RET_PK(l0, h0), vf0, R[kb], 0, 0, 0); R[kb] = __builtin_amdgcn_mfma_f32_32x32x16_bf16(RET_PK(l1, h1), vf1, R[kb], 0, 0, 0);
#pragma unroll
      for (int r = 0; r < 16; ++r) R[kb][r] *= gC; }
    LAS float* OUT = (LAS float*)(lds + R_OUT);
#pragma unroll
    for (int r = 0; r < 16; ++r) OUT[crow(r, hi) * OP + 32 * w + r32] = o[r] * qd[r];
    asm volatile("s_waitcnt lgkmcnt(0)\n\ts_barrier" ::: "memory");
    { const LAS f32x4* orow = (const LAS f32x4*)(OUT + erow * OP + ec0); f32x4 v[4]; float ssq = 0.f;
#pragma unroll
      for (int k = 0; k < 4; ++k) { v[k] = orow[k]; ssq += (v[k][0] * v[k][0] + v[k][1] * v[k][1]) + (v[k][2] * v[k][2] + v[k][3] * v[k][3]); }
      ssq += __shfl_xor(ssq, 1); ssq += __shfl_xor(ssq, 2); ssq += __shfl_xor(ssq, 4); ssq += __shfl_xor(ssq, 8);
      const float rstd = rsqrtf(ssq * (1.f / 256.f) + EPS);
      const float* gp = gret + h * 256 + ec0; f32x4 a0, a1, a2, a3; pg8::unpack8(gr0, a0, a1); pg8::unpack8(gr1, a2, a3);
      f32x4 gate[4] = {a0, a1, a2, a3};
#pragma unroll
      for (int k = 0; k < 4; ++k) { const f32x4 gg = *(const f32x4*)(gp + 4 * k);
#pragma unroll
        for (int e = 0; e < 4; ++e) v[k][e] = v[k][e] * rstd * gg[e] * (gate[k][e] * sigmoidf_(gate[k][e])); }
      bf16* dst = yr + erow_g * PP + h * 256 + ec0;
      *(u32x4*)dst = pg8::pack8(v[0], v[1]); *(u32x4*)(dst + 8) = pg8::pack8(v[2], v[3]); }
  }
  asm volatile("s_waitcnt lgkmcnt(0)\n\ts_barrier" ::: "memory");
#undef RET_LOADS
#undef RET_WRITE
}
#undef RET_PK
#undef RET_PK4
}

struct LamPtrs { const float* q1; const float* k1; const float* q2; const float* k2; };
__device__ __forceinline__ float compute_lam(const LamPtrs& L, int lane) {
    const float a = wave_sum(L.q1[lane] * L.k1[lane]), b = wave_sum(L.q2[lane] * L.k2[lane]);
    return __expf(a) - __expf(b) + LAM_INIT;
}

#define XB_TMO      128
#define XB_XCNT(j)  (256  + 64 * (j))
#define XB_XSUB(j)  (1280 + 64 * (j))
#define XB_XGEN(j)  (2304 + 64 * (j))
#define XB_TOP      3328
#define XB_TOPGEN   3392
#define XCD_BAR_WORDS 3456
#define XB_SPIN_CAP (1u << 23)
__device__ __forceinline__ unsigned xb_ld(unsigned* p)              { return __hip_atomic_load(p, __ATOMIC_RELAXED, __HIP_MEMORY_SCOPE_AGENT); }
__device__ __forceinline__ unsigned xb_add(unsigned* p, unsigned v) { return __hip_atomic_fetch_add(p, v, __ATOMIC_RELAXED, __HIP_MEMORY_SCOPE_AGENT); }
__device__ __forceinline__ unsigned xb_xcc_id() { return (unsigned)__builtin_amdgcn_s_getreg((3 << 11) | 20) & 0xFu; }
#define XB_SPIN(cond, bar) do { unsigned _sp = 0; while (cond) { __builtin_amdgcn_s_sleep(1); \
    if ((++_sp & 255u) == 0u) { if (xb_ld(&(bar)[XB_TMO])) break; if (_sp > XB_SPIN_CAP) { atomicAdd(&(bar)[XB_TMO], 1u); break; } } } } while (0)
struct XcdBarrier { unsigned* bar; unsigned x; volatile LAS unsigned* st; };
__device__ __forceinline__ XcdBarrier xcd_barrier_post(unsigned* bar, volatile LAS unsigned* st) {
    XcdBarrier b; b.bar = bar; b.x = xb_xcc_id(); b.st = st;
    if (threadIdx.x == 0) (void)xb_add(&bar[XB_XCNT(b.x)], 1u);
    return b;
}
__device__ __forceinline__ void xcd_barrier_complete(unsigned* bar, unsigned x, unsigned& nloc, unsigned& nx) {
    const unsigned G = gridDim.x * gridDim.y * gridDim.z;
    unsigned sum, cnt, mine, sp = 0u;
    for (;;) {
        sum = 0u; cnt = 0u; mine = 0u;
#pragma unroll
        for (unsigned j = 0; j < 16; ++j) { const unsigned c = xb_ld(&bar[XB_XCNT(j)]); sum += c; cnt += (c > 0u) ? 1u : 0u; mine = (j == x) ? c : mine; }
        if (sum == G) break;
        __builtin_amdgcn_s_sleep(1);
        if ((++sp & 255u) == 0u) { if (xb_ld(&bar[XB_TMO])) break; if (sp > XB_SPIN_CAP) { atomicAdd(&bar[XB_TMO], 1u); break; } }
    }
    nloc = mine > 0u ? mine : 1u; nx = cnt > 0u ? cnt : 1u;
}
__device__ __forceinline__ void xcd_barrier(const XcdBarrier& b) {
    asm volatile("s_waitcnt vmcnt(0)" ::: "memory");
    __syncthreads();
    if (threadIdx.x == 0) {
        unsigned* bar = b.bar;
        __builtin_amdgcn_s_waitcnt(0);
        unsigned nloc = b.st[0], nx = b.st[1];
        if (nloc == 0u) { xcd_barrier_complete(bar, b.x, nloc, nx); b.st[0] = nloc; b.st[1] = nx; }
        const unsigned old = xb_add(&bar[XB_XSUB(b.x)], 1u);
        const unsigned gen = old / nloc;
        if (old + 1u == (gen + 1u) * nloc) {
            __builtin_amdgcn_fence(__ATOMIC_RELEASE, "agent");
            asm volatile("s_waitcnt vmcnt(0)" ::: "memory");
            const unsigned og = xb_add(&bar[XB_TOP], 1u);
            const unsigned tg = og / nx;
            if (og + 1u == (tg + 1u) * nx) xb_add(&bar[XB_TOPGEN], 1u);
            else XB_SPIN(xb_ld(&bar[XB_TOPGEN]) == tg, bar);
            __builtin_amdgcn_fence(__ATOMIC_ACQUIRE, "agent");
            xb_add(&bar[XB_XGEN(b.x)], 1u);
            asm volatile("s_waitcnt vmcnt(0)" ::: "memory");
        } else {
            XB_SPIN(xb_ld(&bar[XB_XGEN(b.x)]) == gen, bar);
            __builtin_amdgcn_fence(__ATOMIC_ACQUIRE, "agent");
            asm volatile("s_waitcnt vmcnt(0)" ::: "memory");
        }
    }
    __syncthreads();
}

constexpr int NWAVES = 8;
constexpr int LDS_BYTES = 147456, LDSCTL_OFF = LDS_BYTES - 1024, MISC_OFF = LDSCTL_OFF + 320;
static_assert(att::A_G + 512 <= LDSCTL_OFF && att::A_END <= att::A_G && ret::R_END <= att::A_G && 7 * 16384 + 8448 <= att::A_G && pg8::STAGE_BYTES <= LDSCTL_OFF && ret::R_END <= LDSCTL_OFF, "LDS map");
constexpr int CW_QUEUE = 16384;
constexpr int N_PHASES = 10;

struct P0Item { const float* W; const float* gain; bf16* WT; int N, ldt, k0, n0; };
__device__ __forceinline__ void p0_load(const P0Item& I, int lane, f32x4 (&v)[10]) {
    const int c = lane & 7;
    const float* gp = I.gain ? I.gain + I.k0 + 8 * c : I.W;
    v[8] = *(const f32x4*)gp; v[9] = *(const f32x4*)(gp + 4);
#pragma unroll
    for (int i = 0; i < 8; ++i) v[i] = *(const f32x4*)(I.W + (size_t)(I.k0 + 8 * i + (lane >> 3)) * I.N + I.n0 + 4 * c);
}
__device__ __forceinline__ void p0_store(const P0Item& I, int lane, const f32x4 (&v)[10], LAS float* scr) {
    const int c = lane & 7;
    const f32x4 one = {1.f, 1.f, 1.f, 1.f}; const f32x4 g0 = I.gain ? v[8] : one, g1 = I.gain ? v[9] : one;
#pragma unroll
    for (int i = 0; i < 8; ++i) { LAS float* d = scr + (8 * i + (lane >> 3)) * 33 + 4 * c; d[0] = v[i].x; d[1] = v[i].y; d[2] = v[i].z; d[3] = v[i].w; }
    LDS_WAIT(); asm volatile("" ::: "memory");
#pragma unroll
    for (int j = 0; j < 4; ++j) { const int n = (lane >> 3) + 8 * j; const LAS float* s = scr + (8 * c) * 33 + n;
        u32x4 o; o.x = pk2(s[0 * 33] * g0.x, s[1 * 33] * g0.y); o.y = pk2(s[2 * 33] * g0.z, s[3 * 33] * g0.w); o.z = pk2(s[4 * 33] * g1.x, s[5 * 33] * g1.y); o.w = pk2(s[6 * 33] * g1.z, s[7 * 33] * g1.w);
        *(u32x4*)(I.WT + (size_t)(I.n0 + n) * I.ldt + I.k0 + 8 * c) = o; }
    LDS_WAIT(); asm volatile("" ::: "memory");
}
template <int NR> __device__ __forceinline__ void prep_rows(const float* __restrict__ xrow, const float* __restrict__ g, bf16* __restrict__ xnrow, const float* __restrict__ prow, bf16* __restrict__ pbrow, int lane) {
    f32x4 v[NR][4], pv[NR];
#pragma unroll
    for (int r = 0; r < NR; ++r) {
#pragma unroll
        for (int j = 0; j < 4; ++j) v[r][j] = ((const f32x4*)(xrow + (size_t)r * D))[lane + 64 * j];
        pv[r] = ((const f32x4*)(prow + (size_t)r * PLE))[lane]; }
    f32x4 gg[4];
#pragma unroll
    for (int j = 0; j < 4; ++j) gg[j] = ((const f32x4*)g)[lane + 64 * j];
#pragma unroll
    for (int r = 0; r < NR; ++r) { float s = 0.f;
#pragma unroll
        for (int j = 0; j < 4; ++j) s += pg8::sumsq4(v[r][j]);
        const float rstd = rsqrtf(wave_sum(s) * (1.f / D) + EPS);
        u32x2* o = (u32x2*)(xnrow + (size_t)r * D) + lane;
#pragma unroll
        for (int j = 0; j < 4; ++j) { u32x2 w; w.x = pk2(v[r][j].x * rstd * gg[j].x, v[r][j].y * rstd * gg[j].y); w.y = pk2(v[r][j].z * rstd * gg[j].z, v[r][j].w * rstd * gg[j].w); o[64 * j] = w; }
        u32x2 w; w.x = pk2(pv[r].x, pv[r].y); w.y = pk2(pv[r].z, pv[r].w); ((u32x2*)(pbrow + (size_t)r * D))[lane] = w; }
}
template <int NR> __device__ __forceinline__ void final_rows(const bf16* __restrict__ x3row, float* __restrict__ orow, const float* __restrict__ ss, const float* __restrict__ g, int row, int lane) {
    u32x4 xv[NR][2]; float sq[NR];
#pragma unroll
    for (int r = 0; r < NR; ++r) { sq[r] = ss[(size_t)(row + r) * 16 + (lane & 15)];
#pragma unroll
        for (int j = 0; j < 2; ++j) xv[r][j] = ((const u32x4*)(x3row + (size_t)r * D))[lane + 64 * j]; }
    f32x4 gg[4];
#pragma unroll
    for (int j = 0; j < 2; ++j) { gg[2 * j] = ((const f32x4*)g)[2 * lane + 128 * j]; gg[2 * j + 1] = ((const f32x4*)g)[2 * lane + 128 * j + 1]; }
#pragma unroll
    for (int r = 0; r < NR; ++r) { float q = sq[r];
        q += __shfl_xor(q, 1); q += __shfl_xor(q, 2); q += __shfl_xor(q, 4); q += __shfl_xor(q, 8);
        const float rstd = rsqrtf(q * (1.f / D) + EPS);
        f32x4* o = (f32x4*)(orow + (size_t)r * D) + 2 * lane;
#pragma unroll
        for (int j = 0; j < 2; ++j) { f32x4 v0, v1; pg8::unpack8(xv[r][j], v0, v1); o[128 * j] = v0 * rstd * gg[2 * j]; o[128 * j + 1] = v1 * rstd * gg[2 * j + 1]; } }
}

struct Args { const float* in[20]; float* out; unsigned char* ws; int ph_lo, ph_hi; };
typedef const __attribute__((address_space(4))) Args* KArgs;
__device__ __forceinline__ KArgs kargs() { KArgs p = (KArgs)__builtin_amdgcn_kernarg_segment_ptr(); asm volatile("" : "+s"(p)); return p; }
#if MK_PER_PHASE
#define IN(k) (ka->ph_lo <= (k) && (k) < ka->ph_hi)
#define GRID_BAR(k) do { } while (0)
#else
#define IN(k) true
#define GRID_BAR(k) do { if ((k) + 1 < N_PHASES) { XcdBarrier b_; b_.bar = (unsigned*)(ka->ws + WS_CTL) + CW_BAR; b_.x = xb_xcc_id(); b_.st = (volatile LAS unsigned*)(lds + MISC_OFF) + 8; xcd_barrier(b_); } } while (0)
#endif
#define WSPTRS(wsb) \
    bf16 *WIN = (bf16*)((wsb) + WS_WIN), *WBD = (bf16*)((wsb) + WS_WBD), *WBR = (bf16*)((wsb) + WS_WBR), *WOUT = (bf16*)((wsb) + WS_WOUT), *W1 = (bf16*)((wsb) + WS_W1), *W2 = (bf16*)((wsb) + WS_W2), *WPG = (bf16*)((wsb) + WS_WPG), *WPLE = (bf16*)((wsb) + WS_WPLE); \
    float* SS1 = (float*)((wsb) + WS_SS); float* SS2 = SS1 + (size_t)MG * 16; float* SS3 = SS2 + (size_t)MG * 16; \
    bf16 *XN = (bf16*)ka->out, *PB = (bf16*)ka->out + (size_t)M * D, *MIX = (bf16*)((wsb) + WS_MIX), *PROJ = (bf16*)((wsb) + WS_PROJ), *HID = (bf16*)((wsb) + WS_PROJ); \
    bf16 *YA = PROJ + O_QA, *YR = PROJ + O_VR; \
    (void)WIN; (void)WBD; (void)WBR; (void)WOUT; (void)W1; (void)W2; (void)WPG; (void)WPLE; (void)SS1; (void)SS2; (void)SS3; (void)PB; (void)XN; (void)YA; (void)YR; (void)MIX; (void)PROJ; (void)HID
#define LANEINFO() int tid_ = threadIdx.x; asm volatile("" : "+v"(tid_)); const int tid = tid_, lane = tid & 63, wave = __builtin_amdgcn_readfirstlane(tid >> 6), G = gridDim.x, gw = (int)blockIdx.x * NWAVES + wave, NGW = G * NWAVES; (void)lane; (void)gw; (void)NGW; (void)G

__global__ void __launch_bounds__(NWAVES * 64, 2) mk_fwd(Args args_unused) {
    extern __shared__ __attribute__((aligned(16))) unsigned char lds_raw[];
    LAS unsigned char* lds = (LAS unsigned char*)lds_raw;
    for (int u = threadIdx.x; u < (LDS_BYTES - LDSCTL_OFF) / 4; u += NWAVES * 64) ((LAS unsigned*)(lds + LDSCTL_OFF))[u] = 0u;
    __syncthreads();
    if (!MK_PER_PHASE) { KArgs ka = kargs(); (void)xcd_barrier_post((unsigned*)(ka->ws + WS_CTL) + CW_BAR, (volatile LAS unsigned*)(lds + MISC_OFF) + 8); }

    { KArgs ka = kargs();
    if (IN(0)) {
        LANEINFO(); unsigned char* ws = ka->ws; WSPTRS(ws);
        LAS float* scr = (LAS float*)(lds + wave * 16384);
        constexpr int I_IN = (D / 64) * (DIN / 32), I_SQ = (D / 64) * (D / 32), I_1 = (D / 64) * (FF / 32), I_2 = (FF / 64) * (D / 32), I_PL = (PLE / 64) * (D / 32);
        constexpr int NITEMS = I_IN + 4 * I_SQ + I_1 + I_2 + I_PL;
        auto decode = [&](int it) { P0Item I; int r = it, sh;
            if (r < I_IN) { I.W = ka->in[3]; I.gain = nullptr; I.WT = WIN; I.N = DIN; I.ldt = D; sh = 8; }
            else if ((r -= I_IN) < I_SQ) { I.W = ka->in[10]; I.gain = nullptr; I.WT = WBD; I.N = D; I.ldt = D; sh = 5; }
            else if ((r -= I_SQ) < I_SQ) { I.W = ka->in[11]; I.gain = nullptr; I.WT = WBR; I.N = D; I.ldt = D; sh = 5; }
            else if ((r -= I_SQ) < I_SQ) { I.W = ka->in[12]; I.gain = nullptr; I.WT = WOUT; I.N = D; I.ldt = D; sh = 5; }
            else if ((r -= I_SQ) < I_SQ) { I.W = ka->in[17]; I.gain = ka->in[16]; I.WT = WPG; I.N = D; I.ldt = D; sh = 5; }
            else if ((r -= I_SQ) < I_1) { I.W = ka->in[14]; I.gain = ka->in[13]; I.WT = W1; I.N = FF; I.ldt = D; sh = 7; }
            else if ((r -= I_1) < I_2) { I.W = ka->in[15]; I.gain = nullptr; I.WT = W2; I.N = D; I.ldt = FF; sh = 5; }
            else { r -= I_2; I.W = ka->in[18]; I.gain = nullptr; I.WT = WPLE; I.N = D; I.ldt = D; sh = 5; }
            I.k0 = 64 * (r >> sh); I.n0 = 32 * (r & ((1 << sh) - 1)); return I; };
        { int it = gw; P0Item I{}; f32x4 cur[10], nxt[10];
          if (it < NITEMS) { I = decode(it); p0_load(I, lane, cur); }
          for (; it + NGW < NITEMS; it += NGW) {
              const P0Item In = decode(it + NGW); p0_load(In, lane, nxt);
              p0_store(I, lane, cur, scr);
              I = In;
#pragma unroll
              for (int i = 0; i < 10; ++i) cur[i] = nxt[i]; }
          if (it < NITEMS) p0_store(I, lane, cur, scr); }
        const float* x = ka->in[0]; const float* p = ka->in[1]; const float* g_mix = ka->in[2];
        for (int m = gw * 4; m < M; m += NGW * 4) prep_rows<4>(x + (size_t)m * D, g_mix, XN + (size_t)m * D, p + (size_t)m * PLE, PB + (size_t)m * D, lane);
        GRID_BAR(0);
    } }
    { KArgs ka = kargs();
    if (IN(1)) {
        unsigned char* ws = ka->ws; WSPTRS(ws);
        pg8::Gemm gm{XN, WIN, XN, WIN, D, D, D, D}; pg8::StaticOrder So; So.init(M, PP, gridDim.x, (int)blockIdx.x, 1);
        pg8::EpiProj E{PROJ};
        pg8::gemm_phase<pg8::EpiProj, true>(lds, gm, So, E);
        GRID_BAR(1);
    } }
    { KArgs ka = kargs();
    if (IN(2)) {
        LANEINFO(); unsigned char* ws = ka->ws; WSPTRS(ws);
        const LamPtrs L{ka->in[4], ka->in[5], ka->in[6], ka->in[7]};
        const float lam = __builtin_bit_cast(float, __builtin_amdgcn_readfirstlane(__builtin_bit_cast(int, compute_lam(L, lane)))); const float* g_diff = ka->in[8]; const float* g_ret = ka->in[9];
        { unsigned* qhead = (unsigned*)(ws + WS_CTL) + CW_QUEUE; volatile LAS unsigned* slot = (volatile LAS unsigned*)(lds + MISC_OFF) + 16;
          constexpr int NCHAINS = NB * 4, NATT = NB * 8 * 16, NUNITS = NCHAINS + NATT;
          if (tid < 128) ((LAS float*)(lds + att::A_G))[tid] = g_diff[tid] * (1.f - LAM_INIT);
          unsigned nxt_ = 0u; if (tid == 0) nxt_ = __hip_atomic_fetch_add(qhead, 1u, __ATOMIC_RELAXED, __HIP_MEMORY_SCOPE_AGENT);
          for (int n_ = 0;; ++n_) {
              if (tid == 0) { slot[n_ & 1] = nxt_; }
              asm volatile("s_waitcnt lgkmcnt(0)\n\ts_barrier" ::: "memory"); const int item = (int)slot[n_ & 1];
              if (tid == 0) nxt_ = __hip_atomic_fetch_add(qhead, 1u, __ATOMIC_RELAXED, __HIP_MEMORY_SCOPE_AGENT);
              if (item >= NUNITS) break;
              if (item < NCHAINS) { ret::ret_chain(lds, PROJ, YR, item >> 2, item & 3, g_ret); continue; }
              const int a_ = item - NCHAINS, r_ = a_ & 1023, bh = r_ >> 2, qb = 4 * (3 - (a_ >> 10)) + 3 - (r_ & 3);
              att::attn_unit(lds, PROJ, YA, bh >> 3, bh & 7, qb, lam, g_diff);
          } }
        GRID_BAR(2);
    } }
    { KArgs ka = kargs();
    if (IN(3)) {
        unsigned char* ws = ka->ws; WSPTRS(ws);
        const bf16* WG = WIN + (size_t)W_GATE_ROW * D;
        pg8::Gemm gm{XN, WG, XN, WG, D, D, D, D}; pg8::StaticOrder So; So.init(M, 2 * D, gridDim.x, (int)blockIdx.x, 1);
        pg8::EpiGate E{PROJ + O_GA};
        pg8::gemm_phase<pg8::EpiGate, true>(lds, gm, So, E);
        GRID_BAR(3);
    } }
    { KArgs ka = kargs();
    if (IN(4)) {
        unsigned char* ws = ka->ws; WSPTRS(ws);
        pg8::Gemm gm{YA, WBD, YR, WBR, PP, D, D, D}; pg8::StaticOrder So; So.init(M, D, gridDim.x, (int)blockIdx.x, 2);
        pg8::EpiMix E{PROJ, MIX};
        pg8::gemm_phase<pg8::EpiMix, true>(lds, gm, So, E);
        GRID_BAR(4);
    } }
    { KArgs ka = kargs();
    if (IN(5)) {
        unsigned char* ws = ka->ws; WSPTRS(ws);
        pg8::Gemm gm{MIX, WOUT, MIX, WOUT, D, D, D, D}; pg8::StaticOrder So; So.init(M, D, gridDim.x, (int)blockIdx.x, 1);
        pg8::EpiRes<false> E{ka->in[0], XN, SS1};
        pg8::gemm_phase<pg8::EpiRes<false>, true>(lds, gm, So, E);
        GRID_BAR(5);
    } }
    { KArgs ka = kargs();
    if (IN(6)) {
        unsigned char* ws = ka->ws; WSPTRS(ws);
        pg8::Gemm gm{XN, W1, XN, W1, D, D, D, D}; pg8::StaticOrder So; So.init(M, FF, gridDim.x, (int)blockIdx.x, 1);
        pg8::EpiHid E{SS1, HID};
        pg8::gemm_phase<pg8::EpiHid, true>(lds, gm, So, E);
        GRID_BAR(6);
    } }
    { KArgs ka = kargs();
    if (IN(7)) {
        unsigned char* ws = ka->ws; WSPTRS(ws);
        pg8::Gemm gm{HID, W2, HID, W2, FF, FF, FF, FF}; pg8::StaticOrder So; So.init(M, D, gridDim.x, (int)blockIdx.x, 1);
        pg8::EpiRes<true> E{nullptr, XN, SS2};
        pg8::gemm_phase<pg8::EpiRes<true>, true>(lds, gm, So, E);
        GRID_BAR(7);
    } }
    { KArgs ka = kargs();
    if (IN(8)) {
        unsigned char* ws = ka->ws; WSPTRS(ws);
        pg8::Gemm gm{PB, WPLE, XN, WPG, D, D, PLE, D}; pg8::StaticOrder So; So.init(M, D, gridDim.x, (int)blockIdx.x, 2);
        pg8::EpiPle E{SS2, MIX, XN, SS3};
        pg8::gemm_phase<pg8::EpiPle, true>(lds, gm, So, E);
        GRID_BAR(8);
    } }
    { KArgs ka = kargs();
    if (IN(9)) {
        LANEINFO(); unsigned char* ws = ka->ws; WSPTRS(ws);
        float* og = ka->out; const float* g_final = ka->in[19];
        for (int m = gw * 4; m < M; m += NGW * 4) final_rows<4>(MIX + (size_t)m * D, og + (size_t)m * D, SS3, g_final, m, lane);
    } }
}

extern "C" void kernel_launch(void* const* d_in, const int* in_sizes, int n_in, void* d_out, int out_size, void* d_ws, size_t ws_size, hipStream_t stream) {
    static int grid = 0;
    if (grid == 0) {
        if (n_in != 20 || in_sizes[0] != M * D || out_size != M * D || ws_size < WS_END) { fprintf(stderr, "kernel_launch: unexpected shapes (n_in %d, ws %zu)\n", n_in, ws_size); grid = -1; return; }
        int dev = 0, cus = 0, per_cu = 0;
        if (hipGetDevice(&dev) != hipSuccess || hipDeviceGetAttribute(&cus, hipDeviceAttributeMultiprocessorCount, dev) != hipSuccess) { grid = -1; return; }
        if (hipFuncSetAttribute((const void*)mk_fwd, hipFuncAttributeMaxDynamicSharedMemorySize, LDS_BYTES) != hipSuccess) { fprintf(stderr, "kernel_launch: hipFuncSetAttribute failed\n"); grid = -1; return; }
        if (hipOccupancyMaxActiveBlocksPerMultiprocessor(&per_cu, (const void*)mk_fwd, NWAVES * 64, LDS_BYTES) != hipSuccess || per_cu < 1) { fprintf(stderr, "kernel_launch: occupancy query says %d\n", per_cu); (void)hipGetLastError(); grid = -1; return; }
        grid = cus;
    }
    if (grid < 0) return;
    if (hipMemsetAsync((char*)d_ws + WS_CTL, 0, CTL_ZERO_BYTES, stream) != hipSuccess) return;
    Args a{};
    for (int i = 0; i < 20; ++i) a.in[i] = (const float*)d_in[i];
    a.out = (float*)d_out; a.ws = (unsigned char*)d_ws;
#if MK_PER_PHASE
    for (int ph = 0; ph < N_PHASES; ++ph) { a.ph_lo = ph; a.ph_hi = ph + 1; hipLaunchKernelGGL(mk_fwd, dim3(grid), dim3(NWAVES * 64), LDS_BYTES, stream, a); }
#else
    a.ph_lo = 0; a.ph_hi = N_PHASES;
    hipLaunchKernelGGL(mk_fwd, dim3(grid), dim3(NWAVES * 64), LDS_BYTES, stream, a);
#endif
}
```

```cpp
#include <hip/hip_runtime.h>
#include <cstdint>
#include <cstdio>

#ifndef MK_PER_PHASE
#define MK_PER_PHASE 0
#endif

typedef unsigned short bf16;
typedef unsigned u32x4 __attribute__((ext_vector_type(4)));
typedef unsigned u32x2 __attribute__((ext_vector_type(2)));
typedef float f32x4 __attribute__((ext_vector_type(4)));
typedef float f32x2 __attribute__((ext_vector_type(2)));
#define LAS __attribute__((address_space(3)))
#define GAS __attribute__((address_space(1)))

constexpr int D = 1024, NB = 32, S = 2048, PLE = 256, DIN = 8192, FF = 4096, M = NB * S;
constexpr int MG = M;
constexpr int PP = 6144;
constexpr float EPS = 1e-6f;
constexpr int O_QA = 0, O_KA = 1024, O_VA = 2048, O_QR = 3072, O_KR = 3584, O_VR = 4096, O_GR = 5120, O_GA = 1024, O_GB = 2048;
constexpr int W_GATE_ROW = 6144;
constexpr float LOG2E = 1.4426950408889634f;
constexpr float QA_SCALE = 0.125f * LOG2E;
constexpr float KR_SCALE = 0.08838834764831845f;
constexpr int RCH = 32;
constexpr float LAM_INIT = 0.2f;

constexpr size_t MiB = 1u << 20;
constexpr size_t WS_CTL = 0, CTL_ZERO_BYTES = 128 * 1024;
constexpr size_t WS_WIN = 1 * MiB, WS_WBD = 17 * MiB, WS_WBR = 19 * MiB, WS_WOUT = 21 * MiB, WS_W1 = 23 * MiB, WS_W2 = 31 * MiB, WS_WPG = 39 * MiB, WS_WPLE = 41 * MiB;
constexpr size_t WS_SS = 44 * MiB;
constexpr size_t WS_MIX = 56 * MiB;
constexpr size_t WS_PROJ = 184 * MiB;
constexpr size_t WS_END = 952 * MiB;
constexpr int CW_BAR = 4096;

__device__ __forceinline__ float bf2f(bf16 v) { return __uint_as_float((unsigned)v << 16); }
__device__ __forceinline__ bf16 f2bf(float f) { unsigned u = __float_as_uint(f); return (bf16)((u + 0x7fffu + ((u >> 16) & 1u)) >> 16); }
__device__ __forceinline__ unsigned pk2(float lo, float hi) { return (unsigned)f2bf(lo) | ((unsigned)f2bf(hi) << 16); }
__device__ __forceinline__ float wave_sum(float v) {
#pragma unroll
    for (int o = 1; o < 64; o <<= 1) v += __shfl_xor(v, o);
    return v;
}
__device__ __forceinline__ float wave_max(float v) {
#pragma unroll
    for (int o = 1; o < 64; o <<= 1) v = fmaxf(v, __shfl_xor(v, o));
    return v;
}
__device__ __forceinline__ float sum_fq(float v) {
    { auto r = __builtin_amdgcn_permlane16_swap(__float_as_uint(v), __float_as_uint(v), false, false); v = __uint_as_float(r[0]) + __uint_as_float(r[1]); }
    { auto r = __builtin_amdgcn_permlane32_swap(__float_as_uint(v), __float_as_uint(v), false, false); v = __uint_as_float(r[0]) + __uint_as_float(r[1]); }
    return v; }
__device__ __forceinline__ float sigmoidf_(float v) { return __builtin_amdgcn_rcpf(1.f + __builtin_amdgcn_exp2f(-v * LOG2E)); }
__device__ __forceinline__ float ret_log2gamma(int h) { return h == 0 ? -0.04580368961312479f : h == 1 ? -0.02272007650008353f : h == 2 ? -0.011315313227834146f : -0.005646563141142063f; }
#define LDS_WAIT() asm volatile("s_waitcnt lgkmcnt(0)" ::: "memory")

namespace pg8 {
#define PG8_LAS __attribute__((address_space(3)))
typedef unsigned short bf16_t;
typedef short bf16x8 __attribute__((ext_vector_type(8)));
constexpr int BM = 256, BK = 64, HALF = 128, HTB = HALF * BK * 2, STAGE_BYTES = 8 * HTB, NXCD = 8, WGM = 8;
__host__ __device__ __forceinline__ int lds_byte(int r, int c) { const int st = (r >> 4) * 2 + (c >> 5), rr = r & 15, cc = c & 31, ob = rr * 64 + cc * 2; return st * 1024 + (ob ^ (((ob >> 9) & 1) << 5)); }
__host__ __device__ __forceinline__ void stage_rc(int b, int& R, int& C) { const int st = b / 1024, sb = b % 1024, swz = sb ^ (((sb >> 9) & 1) << 5); R = (st >> 1) * 16 + swz / 64; C = (st & 1) * 32 + (swz % 64) / 2; }
__host__ __device__ __forceinline__ int perm32(int rho) { const int n = rho >> 4, i = rho & 15; return 8 * (i >> 2) + 4 * n + (i & 3); }

struct Unit { int pm, pn, z; };
struct Gemm { const bf16_t* A0; const bf16_t* B0; const bf16_t* A1; const bf16_t* B1; int lda, ldb, K0, K1; };

struct StaticOrder {
    int nM, nN, nwg, G, c, nz;
    __host__ __device__ void init(int M_, int N_, int G_, int c_, int nz_) { nM = M_ / BM; nN = N_ / BM; nwg = nM * nN; G = G_; c = c_; nz = nz_; }
    __host__ __device__ bool next(int i, Unit& u) const {
        const int ti = i / nz; u.z = i - ti * nz;
        const long L = (long)ti * G + c; if (L >= nwg) return false;
        int wgid = (int)L; { const int q = nwg / NXCD, r = nwg % NXCD, xcd = wgid % NXCD, off = wgid / NXCD; wgid = (xcd < r ? xcd * (q + 1) : r * (q + 1) + (xcd - r) * q) + off; }
        const int nig = WGM * nN, gid = wgid / nig, fm = gid * WGM, gsz = (nM - fm) < WGM ? (nM - fm) : WGM;
        u.pm = fm + ((wgid % nig) % gsz); u.pn = (wgid % nig) / gsz; return true;
    }
};
__device__ __forceinline__ unsigned cvt_pk_bf16(float lo, float hi) { unsigned r; asm volatile("v_cvt_pk_bf16_f32 %0, %1, %2" : "=v"(r) : "v"(lo), "v"(hi)); return r; }

template <class Epi, bool ALIGN_EPI>
__device__ __forceinline__ void gemm_phase(PG8_LAS unsigned char* lds, const Gemm g, const StaticOrder& S, const Epi& E) {
    int tid_ = threadIdx.x; asm volatile("" : "+v"(tid_));
    const int tid = tid_, wid = __builtin_amdgcn_readfirstlane(tid >> 6), lane = tid & 63, wr = wid >> 2, wc = wid & 3, fr = lane & 15, fq = lane >> 4;
    unsigned voffA[2], voffB[2];
#pragma unroll
    for (int i = 0; i < 2; ++i) { int R, C; stage_rc(tid * 16 + i * 8192, R, C); const int Rb = Epi::PERM ? ((R & ~31) + perm32(R & 31)) : R;
        voffA[i] = (unsigned)(R * g.lda + C) * 2u; voffB[i] = (unsigned)(Rb * g.ldb + C) * 2u; }
    const size_t kstep = (size_t)(BK * 2);
    const size_t hstepA = (size_t)HALF * g.lda * 2, hstepB = (size_t)HALF * g.ldb * 2;
    const size_t tstepA = 2 * hstepA, tstepB = 2 * hstepB;
    const unsigned ldsw = (unsigned)wid * 1024u;
    const int aoff = lds_byte(wr * 64 + fr, fq * 8), boff = lds_byte(wc * 32 + fr, fq * 8);
#define PG8_SA(b, h) (((b) * 2 + (h)) * HTB)
#define PG8_SB(b, h) ((4 + (b) * 2 + (h)) * HTB)
#define PG8_STAGE(bufoff, gbase, voff) do { _Pragma("unroll") for (int _i = 0; _i < 2; ++_i) \
        __builtin_amdgcn_global_load_lds((const unsigned*)((const char*)(gbase) + (voff)[_i]), (PG8_LAS unsigned*)(lds + (bufoff) + ldsw + _i * 8192), 16, 0, 0); } while (0)
#define PG8_LDA(dst, b, h) do { _Pragma("unroll") for (int m = 0; m < 4; ++m) _Pragma("unroll") for (int k = 0; k < 2; ++k) dst[m][k] = *(const PG8_LAS bf16x8*)(lds + PG8_SA(b, h) + aoff + m * 2048 + k * 1024); } while (0)
#define PG8_LDB(dst, b, h) do { _Pragma("unroll") for (int n = 0; n < 2; ++n) _Pragma("unroll") for (int k = 0; k < 2; ++k) dst[n][k] = *(const PG8_LAS bf16x8*)(lds + PG8_SB(b, h) + boff + n * 2048 + k * 1024); } while (0)
#define PG8_MMA(ai, bj, At, Bt) do { __builtin_amdgcn_s_setprio(1); _Pragma("unroll") for (int m = 0; m < 4; ++m) _Pragma("unroll") for (int n = 0; n < 2; ++n) _Pragma("unroll") for (int k = 0; k < 2; ++k) \
        acc[ai][bj][m][n] = __builtin_amdgcn_mfma_f32_16x16x32_bf16(Bt[n][k], At[m][k], acc[ai][bj][m][n], 0, 0, 0); __builtin_amdgcn_s_setprio(0); } while (0)
#define PG8_WAIT_V(n) asm volatile("s_waitcnt vmcnt(" #n ")" ::: "memory")
#define PG8_WAIT_L(n) asm volatile("s_waitcnt lgkmcnt(" #n ")" ::: "memory")
#define PG8_BAR __builtin_amdgcn_s_barrier()
#define PG8_SCHED __builtin_amdgcn_sched_barrier(0)
    Unit cur, nxt; int ui = 0;
    if (!S.next(0, cur)) return;
    f32x4 acc[2][2][4][2];
#pragma unroll
    for (int a = 0; a < 2; ++a)
#pragma unroll
        for (int b = 0; b < 2; ++b)
#pragma unroll
            for (int m = 0; m < 4; ++m)
#pragma unroll
                for (int n = 0; n < 2; ++n) acc[a][b][m][n] = (f32x4){0.f, 0.f, 0.f, 0.f};
    bf16x8 At[4][2], B0[2][2], B1[2][2];
    const char* cA = (const char*)(cur.z ? g.A1 : g.A0) + (size_t)cur.pm * tstepA; const char* cB = (const char*)(cur.z ? g.B1 : g.B0) + (size_t)cur.pn * tstepB;
    int nt = (cur.z ? g.K1 : g.K0) / BK;
    PG8_STAGE(PG8_SB(0, 0), cB, voffB); PG8_STAGE(PG8_SB(0, 1), cB + hstepB, voffB); PG8_STAGE(PG8_SA(0, 0), cA, voffA); PG8_STAGE(PG8_SA(0, 1), cA + hstepA, voffA);
    if (wr == 1) PG8_BAR;
    PG8_WAIT_V(2); PG8_BAR;
    PG8_STAGE(PG8_SB(1, 0), cB + kstep, voffB); PG8_STAGE(PG8_SA(1, 0), cA + kstep, voffA); PG8_STAGE(PG8_SB(1, 1), cB + hstepB + kstep, voffB);
    PG8_WAIT_V(6); PG8_BAR;
    for (;;) {
        const bool has_next = S.next(ui + 1, nxt);
        const char* nA = has_next ? (const char*)(nxt.z ? g.A1 : g.A0) + (size_t)nxt.pm * tstepA : cA; const char* nB = has_next ? (const char*)(nxt.z ? g.B1 : g.B0) + (size_t)nxt.pn * tstepB : cB;
#define PG8_W1(t) PG8_WAIT_V(8)
#define PG8_TRIP(t, W1) do { \
            const bool last = ((t) == nt - 2); \
            const char* a1 = cA + (size_t)((t) + 1) * kstep; \
            const char* a2 = last ? nA : cA + (size_t)((t) + 2) * kstep; const char* b2 = last ? nB : cB + (size_t)((t) + 2) * kstep; \
            const char* a3 = a2 + kstep; const char* b3 = b2 + kstep; \
              \
            PG8_LDB(B0, 0, 0); PG8_LDB(B1, 0, 1); PG8_SCHED; PG8_LDA(At, 0, 0); PG8_STAGE(PG8_SA(1, 1), a1 + hstepA, voffA); \
            PG8_W1(t); PG8_WAIT_L(0); PG8_BAR; PG8_MMA(0, 0, At, B0); PG8_MMA(0, 1, At, B1); PG8_BAR; PG8_SCHED; \
              \
            PG8_LDA(At, 0, 1); PG8_STAGE(PG8_SB(0, 0), b2, voffB); PG8_STAGE(PG8_SB(0, 1), b2 + hstepB, voffB); PG8_STAGE(PG8_SA(0, 0), a2, voffA); \
            PG8_W1(t); PG8_WAIT_L(0); PG8_BAR; PG8_MMA(1, 0, At, B0); PG8_MMA(1, 1, At, B1); PG8_BAR; PG8_SCHED; \
              \
            PG8_LDB(B0, 1, 0); PG8_LDB(B1, 1, 1); PG8_SCHED; PG8_LDA(At, 1, 0); PG8_STAGE(PG8_SA(0, 1), a2 + hstepA, voffA); \
            PG8_WAIT_V(8); PG8_WAIT_L(0); PG8_BAR; PG8_MMA(0, 0, At, B0); PG8_MMA(0, 1, At, B1); PG8_BAR; PG8_SCHED; \
              \
            PG8_LDA(At, 1, 1); PG8_STAGE(PG8_SB(1, 0), b3, voffB); PG8_STAGE(PG8_SB(1, 1), b3 + hstepB, voffB); PG8_STAGE(PG8_SA(1, 0), a3, voffA); \
            PG8_WAIT_V(8); PG8_WAIT_L(0); PG8_BAR; PG8_MMA(1, 0, At, B0); PG8_MMA(1, 1, At, B1); PG8_BAR; PG8_SCHED; } while (0)
        for (int t = 0; t < nt; t += 2) PG8_TRIP(t, 8);
        if constexpr (ALIGN_EPI) { if (wr == 0) PG8_BAR; }
        bool keep = false;
        if constexpr (Epi::CHAINZ) { if (cur.z == 0) { E.mid(acc, cur, wr, wc, fr, fq); keep = true; } else E(acc, cur, wr, wc, fr, fq); }
        else E(acc, cur, wr, wc, fr, fq);
        if (!has_next) break;
        if (!keep) {
#pragma unroll
        for (int a = 0; a < 2; ++a)
#pragma unroll
            for (int b = 0; b < 2; ++b)
#pragma unroll
                for (int m = 0; m < 4; ++m)
#pragma unroll
                    for (int n = 0; n < 2; ++n) acc[a][b][m][n] = (f32x4){0.f, 0.f, 0.f, 0.f};
        }
        cur = nxt; cA = nA; cB = nB; ++ui; nt = (cur.z ? g.K1 : g.K0) / BK;
        if constexpr (ALIGN_EPI) { if (wr == 1) PG8_BAR; }
    }
    PG8_WAIT_V(0);
    if constexpr (!ALIGN_EPI) { if (wr == 0) PG8_BAR; }
    PG8_BAR;
#undef PG8_TRIP
#undef PG8_W1
#undef PG8_SA
#undef PG8_SB
#undef PG8_STAGE
#undef PG8_LDA
#undef PG8_LDB
#undef PG8_MMA
#undef PG8_WAIT_V
#undef PG8_WAIT_L
#undef PG8_BAR
#undef PG8_SCHED
}

typedef f32x4 AccT[2][2][4][2];
__device__ __forceinline__ u32x4 pack8(const f32x4 v0, const f32x4 v1) { u32x4 w; w.x = cvt_pk_bf16(v0[0], v0[1]); w.y = cvt_pk_bf16(v0[2], v0[3]); w.z = cvt_pk_bf16(v1[0], v1[1]); w.w = cvt_pk_bf16(v1[2], v1[3]); return w; }
__device__ __forceinline__ void unpack8(const u32x4 w, f32x4& v0, f32x4& v1) {
    v0 = (f32x4){__uint_as_float(w.x << 16), __uint_as_float(w.x & 0xffff0000u), __uint_as_float(w.y << 16), __uint_as_float(w.y & 0xffff0000u)};
    v1 = (f32x4){__uint_as_float(w.z << 16), __uint_as_float(w.z & 0xffff0000u), __uint_as_float(w.w << 16), __uint_as_float(w.w & 0xffff0000u)}; }
__device__ __forceinline__ f32x4 sig4(const f32x4 v) { return (f32x4){sigmoidf_(v[0]), sigmoidf_(v[1]), sigmoidf_(v[2]), sigmoidf_(v[3])}; }
__device__ __forceinline__ float sumsq4(const f32x4 v) { return (v[0] * v[0] + v[1] * v[1]) + (v[2] * v[2] + v[3] * v[3]); }
__device__ __forceinline__ float rstd_from_ss(const float* ss, int row, int fq) {
    const f32x4 a = *(const f32x4*)(ss + (size_t)row * 16 + 4 * fq);
    float s = (a[0] + a[1]) + (a[2] + a[3]);
    s = sum_fq(s);
    return rsqrtf(s * (1.f / D) + EPS); }

struct EpiProj { static constexpr bool PERM = true, CHAINZ = false; bf16* O;
    __device__ __forceinline__ void operator()(const AccT& acc, const Unit& u, int wr, int wc, int fr, int fq) const {
        const int row0 = u.pm * BM + wr * 64 + fr, col0 = u.pn * BM + wc * 32 + 8 * fq;
        const bool iskr = (u.pn >= 14 && u.pn < 16);
        const float base = (u.pn < 4) ? QA_SCALE : (iskr ? KR_SCALE : 1.f);
        const float l2g0 = iskr ? ret_log2gamma(2 * (u.pn - 14)) : 0.f, l2g1 = iskr ? ret_log2gamma(2 * (u.pn - 14) + 1) : 0.f;
        float sc[2][4];
#pragma unroll
        for (int m = 0; m < 4; ++m) { const float e = -(float)(((16 * m + fr) & (RCH - 1)) + 1); sc[0][m] = base * __builtin_amdgcn_exp2f(e * l2g0); sc[1][m] = base * __builtin_amdgcn_exp2f(e * l2g1); }
#pragma unroll
        for (int ai = 0; ai < 2; ++ai)
#pragma unroll
            for (int m = 0; m < 4; ++m) { bf16* rowp = O + (size_t)(row0 + ai * HALF + m * 16) * PP + col0;
#pragma unroll
                for (int bj = 0; bj < 2; ++bj) *(u32x4*)(rowp + bj * HALF) = pack8(acc[ai][bj][m][0] * sc[bj][m], acc[ai][bj][m][1] * sc[bj][m]); }
    }
};
struct EpiGate { static constexpr bool PERM = true, CHAINZ = false; bf16* O;
    __device__ __forceinline__ void operator()(const AccT& acc, const Unit& u, int wr, int wc, int fr, int fq) const {
        const int row0 = u.pm * BM + wr * 64 + fr, col0 = u.pn * BM + wc * 32 + 8 * fq;
#pragma unroll
        for (int ai = 0; ai < 2; ++ai)
#pragma unroll
            for (int m = 0; m < 4; ++m) { bf16* rowp = O + (size_t)(row0 + ai * HALF + m * 16) * PP + col0;
#pragma unroll
                for (int bj = 0; bj < 2; ++bj) *(u32x4*)(rowp + bj * HALF) = pack8(acc[ai][bj][m][0], acc[ai][bj][m][1]); }
    }
};
struct EpiMix { static constexpr bool PERM = true, CHAINZ = true; const bf16* proj; bf16* mix;
    __device__ __forceinline__ void mid(AccT& acc, const Unit& u, int wr, int wc, int fr, int fq) const {
        const int row0 = u.pm * BM + wr * 64 + fr, col0 = u.pn * BM + wc * 32 + 8 * fq;
#pragma unroll
        for (int ai = 0; ai < 2; ++ai)
#pragma unroll
            for (int m = 0; m < 4; ++m) { const size_t r = (size_t)(row0 + ai * HALF + m * 16);
#pragma unroll
                for (int bj = 0; bj < 2; ++bj) { const int c = col0 + bj * HALF;
                    f32x4 a0, a1, b0, b1; unpack8(*(const u32x4*)(proj + r * PP + O_GA + c), a0, a1); unpack8(*(const u32x4*)(proj + r * PP + O_GB + c), b0, b1);
#pragma unroll
                    for (int e = 0; e < 4; ++e) {
                        acc[ai][bj][m][0][e] *= (1.f + __builtin_amdgcn_exp2f(-b0[e] * LOG2E)) * __builtin_amdgcn_rcpf(1.f + __builtin_amdgcn_exp2f(-a0[e] * LOG2E));
                        acc[ai][bj][m][1][e] *= (1.f + __builtin_amdgcn_exp2f(-b1[e] * LOG2E)) * __builtin_amdgcn_rcpf(1.f + __builtin_amdgcn_exp2f(-a1[e] * LOG2E)); } } }
    }
    __device__ __forceinline__ void operator()(const AccT& acc, const Unit& u, int wr, int wc, int fr, int fq) const {
        const int row0 = u.pm * BM + wr * 64 + fr, col0 = u.pn * BM + wc * 32 + 8 * fq;
#pragma unroll
        for (int ai = 0; ai < 2; ++ai)
#pragma unroll
            for (int m = 0; m < 4; ++m) { const size_t r = (size_t)(row0 + ai * HALF + m * 16);
#pragma unroll
                for (int bj = 0; bj < 2; ++bj) { const int c = col0 + bj * HALF;
                    f32x4 g0, g1; unpack8(*(const u32x4*)(proj + r * PP + O_GB + c), g0, g1);
                    *(u32x4*)(mix + r * D + c) = pack8(sig4(g0) * acc[ai][bj][m][0], sig4(g1) * acc[ai][bj][m][1]); } }
    }
};
template <bool IN_BF16> struct EpiRes { static constexpr bool PERM = true, CHAINZ = false; const float* xin; bf16* xb; float* ss;
    __device__ __forceinline__ void operator()(const AccT& acc, const Unit& u, int wr, int wc, int fr, int fq) const {
        const int row0 = u.pm * BM + wr * 64 + fr, col0 = u.pn * BM + wc * 32 + 8 * fq;
#pragma unroll
        for (int ai = 0; ai < 2; ++ai)
#pragma unroll
            for (int m = 0; m < 4; ++m) { const size_t r = (size_t)(row0 + ai * HALF + m * 16); float q = 0.f;
#pragma unroll
                for (int bj = 0; bj < 2; ++bj) { const size_t o = r * D + col0 + bj * HALF;
                    f32x4 x0, x1;
                    if (IN_BF16) unpack8(*(const u32x4*)(xb + o), x0, x1); else { x0 = *(const f32x4*)(xin + o); x1 = *(const f32x4*)(xin + o + 4); }
                    const f32x4 v0 = x0 + acc[ai][bj][m][0], v1 = x1 + acc[ai][bj][m][1];
                    *(u32x4*)(xb + o) = pack8(v0, v1);
                    q += sumsq4(v0) + sumsq4(v1); }
                q = sum_fq(q);
                if (fq == 0) ss[r * 16 + u.pn * 4 + wc] = q; }
    }
};
struct EpiHid { static constexpr bool PERM = true, CHAINZ = false; const float* ss; bf16* hid;
    __device__ __forceinline__ void operator()(const AccT& acc, const Unit& u, int wr, int wc, int fr, int fq) const {
        const int row0 = u.pm * BM + wr * 64 + fr, col0 = u.pn * BM + wc * 32 + 8 * fq;
#pragma unroll
        for (int ai = 0; ai < 2; ++ai)
#pragma unroll
            for (int m = 0; m < 4; ++m) { const int r = row0 + ai * HALF + m * 16; const float rstd = rstd_from_ss(ss, r, fq);
#pragma unroll
                for (int bj = 0; bj < 2; ++bj) { f32x4 v0 = acc[ai][bj][m][0] * rstd, v1 = acc[ai][bj][m][1] * rstd;
#pragma unroll
                    for (int e = 0; e < 4; ++e) { v0[e] = fmaxf(v0[e], 0.f); v1[e] = fmaxf(v1[e], 0.f); }
                    *(u32x4*)(hid + (size_t)r * FF + col0 + bj * HALF) = pack8(v0 * v0, v1 * v1); } }
    }
};
struct EpiPle { static constexpr bool PERM = true, CHAINZ = false; const float* ss2; bf16* part; const bf16* x2b; float* ss3;
    __device__ __forceinline__ void operator()(const AccT& acc, const Unit& u, int wr, int wc, int fr, int fq) const {
        const int row0 = u.pm * BM + wr * 64 + fr, col0 = u.pn * BM + wc * 32 + 8 * fq;
#pragma unroll
        for (int ai = 0; ai < 2; ++ai)
#pragma unroll
            for (int m = 0; m < 4; ++m) { const size_t r = (size_t)(row0 + ai * HALF + m * 16); float q = 0.f;
                const float rstd = u.z ? rstd_from_ss(ss2, (int)r, fq) : 1.f;
#pragma unroll
                for (int bj = 0; bj < 2; ++bj) { const size_t o = r * D + col0 + bj * HALF;
                    if (u.z == 0) { *(u32x4*)(part + o) = pack8(acc[ai][bj][m][0], acc[ai][bj][m][1]); }
                    else { f32x4 p0, p1, x0, x1; unpack8(*(const u32x4*)(part + o), p0, p1); unpack8(*(const u32x4*)(x2b + o), x0, x1);
                        const f32x4 v0 = x0 + sig4(acc[ai][bj][m][0] * rstd) * p0, v1 = x1 + sig4(acc[ai][bj][m][1] * rstd) * p1;
                        *(u32x4*)(part + o) = pack8(v0, v1); q += sumsq4(v0) + sumsq4(v1); } }
                if (u.z) { q = sum_fq(q); if (fq == 0) ss3[r * 16 + u.pn * 4 + wc] = q; } }
    }
};
}

namespace att {
typedef short bf16x8 __attribute__((ext_vector_type(8)));
typedef short s16x4 __attribute__((ext_vector_type(4)));
typedef float f32x16 __attribute__((ext_vector_type(16)));
constexpr int SHM_V = 16384, SHM_K = 16384;
constexpr int NBUF = 4, A_V = 0, A_K = NBUF * SHM_V, A_WS = A_K + NBUF * SHM_K, A_X = 0  , XPITCH = 132, X_BYTES = 17408, A_END = A_WS + 2048;
static_assert(4 * X_BYTES <= A_WS, "exchange region inside the tile buffers");
constexpr int A_G = 145408;
constexpr float THR = 8.f;
#define ATT_KSWZ(row, colB) ((row) * 256 + ((colB) ^ (((row) & 7) << 4)))
#define ATT_SBAR() __builtin_amdgcn_sched_barrier(0)
__device__ __forceinline__ int crow(int r, int hi) { return (r & 3) + 8 * (r >> 2) + 4 * hi; }
__device__ __forceinline__ unsigned cvtpk(float lo, float hi) { unsigned r; asm volatile("v_cvt_pk_bf16_f32 %0, %1, %2" : "=v"(r) : "v"(lo), "v"(hi)); return r; }
__device__ __forceinline__ int v_st(int k, int c) { const int kk = (k & ~0xC) | ((k & 4) << 1) | ((k & 8) >> 1); return ((kk >> 3) * 4 + (c >> 5)) * 512 + ((kk & 7) * 32 + (c & 31)) * 2; }
__device__ __forceinline__ int v_rd_base(int lane) { return ((lane & 3) << 3) | (((lane >> 2) & 3) << 6) | (((lane >> 4) & 1) << 5) | (((lane >> 5) & 1) << 8); }
constexpr int v_rd_off(int d0, int ks, int half) { return d0 * 512 + ks * 4096 + half * 2048; }
typedef short v4i16_t __attribute__((ext_vector_type(4)));
__device__ __forceinline__ s16x4 vtr(const LAS unsigned char* p) { return __builtin_bit_cast(s16x4, __builtin_amdgcn_ds_read_tr16_b64_v4i16((LAS v4i16_t*)p)); }
#define ATT_PK(L, H) (bf16x8){L[0], L[1], L[2], L[3], H[0], H[1], H[2], H[3]}
struct VFrag { s16x4 l0, h0, l1, h1, l2, h2, l3, h3; };
template <int D0> __device__ __forceinline__ void vload(VFrag& f, const LAS unsigned char* vp) {
  f.l0 = vtr(vp + v_rd_off(D0, 0, 0)); f.h0 = vtr(vp + v_rd_off(D0, 0, 1)); f.l1 = vtr(vp + v_rd_off(D0, 1, 0)); f.h1 = vtr(vp + v_rd_off(D0, 1, 1));
  f.l2 = vtr(vp + v_rd_off(D0, 2, 0)); f.h2 = vtr(vp + v_rd_off(D0, 2, 1)); f.l3 = vtr(vp + v_rd_off(D0, 3, 0)); f.h3 = vtr(vp + v_rd_off(D0, 3, 1));
}
__device__ __forceinline__ void pv_mma(f32x16& od, const VFrag& f, bf16x8 pa0, bf16x8 pa1, bf16x8 pa2, bf16x8 pa3) {
  od = __builtin_amdgcn_mfma_f32_32x32x16_bf16(pa0, ATT_PK(f.l0, f.h0), od, 0, 0, 0);
  od = __builtin_amdgcn_mfma_f32_32x32x16_bf16(pa1, ATT_PK(f.l1, f.h1), od, 0, 0, 0);
  od = __builtin_amdgcn_mfma_f32_32x32x16_bf16(pa2, ATT_PK(f.l2, f.h2), od, 0, 0, 0);
  od = __builtin_amdgcn_mfma_f32_32x32x16_bf16(pa3, ATT_PK(f.l3, f.h3), od, 0, 0, 0);
}
struct KFrag { bf16x8 a[2], b[2]; };
template <int H> __device__ __forceinline__ void kload(KFrag& k, const LAS unsigned char* Ks, int c, int r32, int hi) {
#pragma unroll
  for (int d = 0; d < 2; ++d) { const int cb = (c * 64 + (2 * H + d) * 16 + hi * 8) * 2;
    k.a[d] = *(const LAS bf16x8*)(Ks + ATT_KSWZ(r32, cb)); k.b[d] = *(const LAS bf16x8*)(Ks + ATT_KSWZ(32 + r32, cb)); }
}
template <bool DOPV> __device__ __forceinline__ void mma_stage(f32x16* o, f32x16& p0, f32x16& p1, const LAS unsigned char* vp, const LAS unsigned char* Ks, bf16x8 pa0, bf16x8 pa1, bf16x8 pa2, bf16x8 pa3,
                                                              const bf16x8* qr, bf16x8 kx0, bf16x8 kx1, bf16x8 qx, int c, int r32, int hi, const VFrag& f0, const KFrag& k0) {
  KFrag k1;
  if (DOPV) {
    VFrag fa = f0, fb;
    vload<1>(fb, vp); ATT_SBAR(); pv_mma(o[0], fa, pa0, pa1, pa2, pa3); ATT_SBAR();
    vload<2>(fa, vp); ATT_SBAR(); pv_mma(o[1], fb, pa0, pa1, pa2, pa3); ATT_SBAR();
    vload<3>(fb, vp); ATT_SBAR(); pv_mma(o[2], fa, pa0, pa1, pa2, pa3); ATT_SBAR();
    kload<1>(k1, Ks, c, r32, hi); ATT_SBAR(); pv_mma(o[3], fb, pa0, pa1, pa2, pa3); ATT_SBAR();
  } else kload<1>(k1, Ks, c, r32, hi);
  p0 = __builtin_amdgcn_mfma_f32_32x32x16_bf16(kx0, qx, f32x16{}, 0, 0, 0); p1 = __builtin_amdgcn_mfma_f32_32x32x16_bf16(kx1, qx, f32x16{}, 0, 0, 0);
#pragma unroll
  for (int d = 0; d < 2; ++d) { p0 = __builtin_amdgcn_mfma_f32_32x32x16_bf16(k0.a[d], qr[d], p0, 0, 0, 0); p1 = __builtin_amdgcn_mfma_f32_32x32x16_bf16(k0.b[d], qr[d], p1, 0, 0, 0); }
#pragma unroll
  for (int d = 0; d < 2; ++d) { p0 = __builtin_amdgcn_mfma_f32_32x32x16_bf16(k1.a[d], qr[2 + d], p0, 0, 0, 0); p1 = __builtin_amdgcn_mfma_f32_32x32x16_bf16(k1.b[d], qr[2 + d], p1, 0, 0, 0); }
}
__device__ __forceinline__ void pv_d0(f32x16* o, const LAS unsigned char* vp, bf16x8 pa0, bf16x8 pa1, bf16x8 pa2, bf16x8 pa3, const VFrag& f0) {
  VFrag fa = f0, fb;
  vload<1>(fb, vp); ATT_SBAR(); pv_mma(o[0], fa, pa0, pa1, pa2, pa3); ATT_SBAR();
  vload<2>(fa, vp); ATT_SBAR(); pv_mma(o[1], fb, pa0, pa1, pa2, pa3); ATT_SBAR();
  vload<3>(fb, vp); ATT_SBAR(); pv_mma(o[2], fa, pa0, pa1, pa2, pa3); ATT_SBAR();
  pv_mma(o[3], fb, pa0, pa1, pa2, pa3);
}
__device__ __forceinline__ float vmax3(float a, float b, float c) { float r; asm("v_max3_f32 %0, %1, %2, %3" : "=v"(r) : "v"(a), "v"(b), "v"(c)); return r; }
__device__ __forceinline__ float vmax2(float a, float b) { float r; asm("v_max_f32 %0, %1, %2" : "=v"(r) : "v"(a), "v"(b)); return r; }
template <bool MASK> __device__ __forceinline__ bool softmax_stage(f32x16& p0, f32x16& p1, float& m_ref, float& l_reg, f32x16* o, bf16x8& pa0, bf16x8& pa1, bf16x8& pa2, bf16x8& pa3,
                                                                  int qrel, int hi, int r32, LAS float* al_l) {
  if (MASK) {
    int qa = qrel - 4 * hi; asm volatile("" : "+v"(qa));
#pragma unroll
    for (int r = 0; r < 16; ++r) { const int cr = (r & 3) + 8 * (r >> 2); p0[r] = (cr > qa) ? -INFINITY : p0[r]; p1[r] = (cr + 32 > qa) ? -INFINITY : p1[r]; }
  }
  float pmax, pmb;
  pmax = vmax3(p0[0], p0[1], p0[2]); pmb = vmax3(p1[0], p1[1], p1[2]);
#pragma unroll
  for (int k = 0; k < 6; ++k) { pmax = vmax3(pmax, p0[3 + 2 * k], p0[4 + 2 * k]); pmb = vmax3(pmb, p1[3 + 2 * k], p1[4 + 2 * k]); }
  pmax = vmax3(pmax, p0[15], p1[15]);
  { const float m2 = vmax2(pmax, pmb); auto rr = __builtin_amdgcn_permlane32_swap(__float_as_uint(m2), __float_as_uint(m2), false, false); pmax = vmax2(__uint_as_float(rr[0]), __uint_as_float(rr[1])); }
  if (__all(pmax < -140.f)) return false;
  float alpha = 1.f;
  if (__builtin_expect(!__all(pmax <= THR), 0)) {
    const float dl = fmaxf(pmax, 0.f); alpha = __builtin_amdgcn_exp2f(-dl); m_ref += dl;
#pragma unroll
    for (int r = 0; r < 16; ++r) { p0[r] -= dl; p1[r] -= dl; }
    if (hi == 0) al_l[r32] = alpha; asm volatile("s_waitcnt lgkmcnt(0)" ::: "memory");
#pragma unroll
    for (int d = 0; d < 4; ++d)
#pragma unroll
      for (int r = 0; r < 16; ++r) o[d][r] *= al_l[crow(r, hi)];
  }
#pragma unroll
  for (int r = 0; r < 16; ++r) { p0[r] = __builtin_amdgcn_exp2f(p0[r]); p1[r] = __builtin_amdgcn_exp2f(p1[r]); }
  float ps = p0[0] + p1[0];
#pragma unroll
  for (int r = 1; r < 16; ++r) { ps += p0[r]; ps += p1[r]; }
  { auto rr = __builtin_amdgcn_permlane32_swap(__float_as_uint(ps), __float_as_uint(ps), false, false); ps = __uint_as_float(rr[0]) + __uint_as_float(rr[1]); }
  l_reg = l_reg * alpha + ps;
#define ATT_PK4(P, BASE, OUT) do { unsigned a0 = cvtpk(P[BASE + 0], P[BASE + 1]), a1 = cvtpk(P[BASE + 2], P[BASE + 3]);   \
    unsigned b0 = cvtpk(P[BASE + 4], P[BASE + 5]), b1 = cvtpk(P[BASE + 6], P[BASE + 7]);                              \
    auto r0 = __builtin_amdgcn_permlane32_swap(a0, b0, false, false); auto r1 = __builtin_amdgcn_permlane32_swap(a1, b1, false, false); \
    u32x4 w = {r0[0], r1[0], r0[1], r1[1]}; OUT = __builtin_bit_cast(bf16x8, w); } while (0)
  ATT_PK4(p0, 0, pa0); ATT_PK4(p0, 8, pa1); ATT_PK4(p1, 0, pa2); ATT_PK4(p1, 8, pa3);
#undef ATT_PK4
  return true;
}

__device__ __forceinline__ void attn_unit(LAS unsigned char* lds, const bf16* __restrict__ proj, bf16* __restrict__ ya, int b, int h, int qb, float lam, const float* __restrict__ gdiff) {
  int tid_ = threadIdx.x; asm volatile("" : "+v"(tid_));
  const int tid = tid_, wid = __builtin_amdgcn_readfirstlane(tid >> 6), lane = tid & 63, r32 = lane & 31, hi = lane >> 5, c = wid >> 2, rg = wid & 3;
  const int q0 = qb * 128, NT = 2 * (qb + 1), qloc = rg * 32 + r32;
  const size_t rowbase = (size_t)b * S;
  const bf16* Kh = proj + rowbase * PP + O_KA + h * 128; const bf16* Vh = proj + rowbase * PP + O_VA + h * 128;
  const bf16* Qw = proj + (rowbase + q0 + qloc) * PP + O_QA + h * 128 + c * 64 + hi * 8;
  LAS unsigned char* V_lds = lds + A_V; LAS unsigned char* K_lds = lds + A_K;
  LAS float* wsf = (LAS float*)(lds + A_WS) + wid * 64; LAS float* li_l = wsf; LAS float* al_l = wsf + 32;
  float l_reg = 0; f32x16 o[4] = {}; bf16x8 qr[4];
#pragma unroll
  for (int d0 = 0; d0 < 4; ++d0) qr[d0] = *(const bf16x8*)(Qw + d0 * 16);
  const LAS unsigned char* vp0 = V_lds + v_rd_base(lane);
  const float slope2 = __builtin_amdgcn_exp2f(-(float)(h + 1)) * LOG2E;
  bf16x8 kx0 = bf16x8{}, kx1 = bf16x8{}; unsigned qxw0 = 0u;
  { const unsigned shi = __float_as_uint(slope2) & 0xffff0000u; const float slo = slope2 - __uint_as_float(shi);
    const unsigned k0 = __float_as_uint((float)r32) >> 16, k1 = __float_as_uint((float)(32 + r32)) >> 16;
    if (hi == 0) { u32x4 w = {k0 | (k0 << 16), 0x3f803f80u, 0x00003f80u, 0u}; kx0 = __builtin_bit_cast(bf16x8, w); w.x = k1 | (k1 << 16); kx1 = __builtin_bit_cast(bf16x8, w);
                   qxw0 = (shi >> 16) | ((unsigned)f2bf(slo) << 16); } }
  const unsigned himask = hi ? 0u : 0xffffffffu;
  unsigned kso[2], vso[2];
#pragma unroll
  for (int j = 0; j < 2; ++j) { const int pc = wid * 2 + j;
    { const int row = 4 * pc + (lane >> 4), ch = (lane & 15) ^ (row & 7); kso[j] = (unsigned)(row * PP + ch * 8); }
    { const int st = 2 * pc + (lane >> 5), i5 = lane & 31, kk = (st >> 2) * 8 + (i5 >> 2), k = (kk & ~0xC) | ((kk & 4) << 1) | ((kk & 8) >> 1), cc = (st & 3) * 32 + (i5 & 3) * 8;
      vso[j] = (unsigned)(k * PP + cc); } }
#define ATT_DMA16(gp, la) asm volatile("s_mov_b32 m0, %1\n\ts_nop 0\n\tglobal_load_lds_dwordx4 %0, off" :: "v"(gp), "s"(la) : "memory", "m0")
#define ATT_DMAK(t, bf) do { _Pragma("unroll") for (int j_ = 0; j_ < 2; ++j_) ATT_DMA16(Kh + (size_t)(64 * (t)) * PP + kso[j_], (unsigned)(size_t)(K_lds + (bf) * SHM_K + (wid * 2 + j_) * 1024)); } while (0)
#define ATT_DMAV(t, bf) do { _Pragma("unroll") for (int j_ = 0; j_ < 2; ++j_) ATT_DMA16(Vh + (size_t)(64 * (t)) * PP + vso[j_], (unsigned)(size_t)(V_lds + (bf) * SHM_V + (wid * 2 + j_) * 1024)); } while (0)
#define ATT_BAR() do { asm volatile("" ::: "memory"); __builtin_amdgcn_s_waitcnt(0xC07F); __builtin_amdgcn_s_barrier(); asm volatile("" ::: "memory"); } while (0)
#define ATT_BARV() do { asm volatile("" ::: "memory"); __builtin_amdgcn_s_waitcnt(0x0070); __builtin_amdgcn_s_barrier(); asm volatile("" ::: "memory"); } while (0)
  f32x16 p0, p1; bf16x8 pa0 = bf16x8{}, pa1 = bf16x8{}, pa2 = bf16x8{}, pa3 = bf16x8{}; bool dopv = false;
#define ATT_ITER(MASK, i_) do { const int i = (i_), t = NT - 1 - i; \
    bf16x8 qx; { const float v_ = slope2 * (float)(64 * t - (q0 + 127)) - m_ref; const unsigned v1_ = __float_as_uint(v_) & 0xffff0000u; const float r1_ = v_ - __uint_as_float(v1_); \
      const unsigned v2_ = __float_as_uint(r1_) & 0xffff0000u; const float r2_ = r1_ - __uint_as_float(v2_); \
      const u32x4 w_ = {qxw0, ((v1_ >> 16) | v2_) & himask, (unsigned)f2bf(r2_) & himask, 0u}; qx = __builtin_bit_cast(bf16x8, w_); } \
    __builtin_amdgcn_s_setprio(2); \
    if (dopv) mma_stage<true>(o, p0, p1, vp0 + ((i - 1) & 3) * SHM_V, K_lds + (i & 3) * SHM_K, pa0, pa1, pa2, pa3, qr, kx0, kx1, qx, c, r32, hi, vf0, kf0); \
    else mma_stage<false>(o, p0, p1, vp0 + ((i - 1) & 3) * SHM_V, K_lds + (i & 3) * SHM_K, pa0, pa1, pa2, pa3, qr, kx0, kx1, qx, c, r32, hi, vf0, kf0); \
    __builtin_amdgcn_s_setprio(0); \
    ATT_BAR(); \
      \
    asm volatile("s_nop 15" : "+v"(p0), "+v"(p1)); \
    dopv = softmax_stage<MASK>(p0, p1, m_ref, l_reg, o, pa0, pa1, pa2, pa3, q0 + qloc - 64 * t, hi, r32, al_l); \
      \
    vload<0>(vf0, vp0 + (i & 3) * SHM_V); kload<0>(kf0, K_lds + ((i + 1) & 3) * SHM_K, c, r32, hi); \
    asm volatile("" ::: "memory"); __builtin_amdgcn_s_waitcnt(0x0F70);     \
      \
    if (i + 2 < NT) { ATT_DMAV(t - 2, (i + 2) & 3); if (i + 3 < NT) ATT_DMAK(t - 3, (i + 3) & 3); } \
    ATT_BAR(); } while (0)
  VFrag vf0; KFrag kf0;
  float m_ref = slope2 * (float)(64 * (NT - 1) - (q0 + 127));
  ATT_DMAK(NT - 1, 0); ATT_DMAV(NT - 1, 0); ATT_DMAK(NT - 2, 1);
  ATT_DMAV(NT - 2, 1);
  asm volatile("" ::: "memory");
  if (NT > 2) { ATT_DMAK(NT - 3, 2); __builtin_amdgcn_s_waitcnt(0x0F74); } else __builtin_amdgcn_s_waitcnt(0x0F72);
  ATT_BAR();
  kload<0>(kf0, K_lds, c, r32, hi); vload<0>(vf0, vp0);
  if (c == 1) ATT_BAR();
  ATT_ITER(true, 0); ATT_ITER(true, 1);
  for (int it = 2; it < NT; ++it) ATT_ITER(false, it);
  if (dopv) pv_d0(o, vp0 + ((NT - 1) & 3) * SHM_V, pa0, pa1, pa2, pa3, vf0);
  if (c == 0) ATT_BAR();
#undef ATT_ITER
  ATT_BAR();
  if (hi == 0) li_l[r32] = l_reg; asm volatile("s_waitcnt lgkmcnt(0)" ::: "memory");
  float rli[16];
#pragma unroll
  for (int r = 0; r < 16; ++r) rli[r] = __builtin_amdgcn_rcpf(li_l[crow(r, hi)]);
  LAS float* X = (LAS float*)(lds + A_X + rg * X_BYTES);
  if (c == 1) {
#pragma unroll
    for (int d0 = 0; d0 < 4; ++d0)
#pragma unroll
      for (int r = 0; r < 16; ++r) X[(d0 * 16 + r) * 64 + lane] = o[d0][r] * rli[r];
  }
  ATT_BAR();
  if (c == 0) {
#pragma unroll
    for (int d0 = 0; d0 < 4; ++d0)
#pragma unroll
      for (int r = 0; r < 16; ++r) o[d0][r] = o[d0][r] * rli[r] - lam * X[(d0 * 16 + r) * 64 + lane];
    asm volatile("s_waitcnt lgkmcnt(0)" ::: "memory"); __builtin_amdgcn_wave_barrier();
#pragma unroll
    for (int d0 = 0; d0 < 4; ++d0)
#pragma unroll
      for (int r = 0; r < 16; ++r) X[crow(r, hi) * XPITCH + d0 * 32 + r32] = o[d0][r];
    asm volatile("s_waitcnt lgkmcnt(0)" ::: "memory"); __builtin_amdgcn_wave_barrier();
    const int row = lane >> 1, half = lane & 1;
    const LAS f32x4* yr = (const LAS f32x4*)(X + row * XPITCH + half * 64);
    f32x4 yv[16]; float ssq = 0.f;
#pragma unroll
    for (int i = 0; i < 16; ++i) { yv[i] = yr[i]; ssq += (yv[i][0] * yv[i][0] + yv[i][1] * yv[i][1]) + (yv[i][2] * yv[i][2] + yv[i][3] * yv[i][3]); }
    ssq += __shfl_xor(ssq, 1);
    const float sc_ = rsqrtf(ssq * (1.f / 128.f) + EPS); const LAS f32x4* Gl = (const LAS f32x4*)(lds + A_G) + half * 16;
    bf16* orow = ya + (rowbase + q0 + rg * 32 + row) * PP + h * 128 + half * 64;
#pragma unroll
    for (int i = 0; i < 8; ++i) { const f32x4 g0 = Gl[2 * i], g1 = Gl[2 * i + 1];
      u32x4 w; w.x = cvtpk(yv[2 * i][0] * sc_ * g0[0], yv[2 * i][1] * sc_ * g0[1]); w.y = cvtpk(yv[2 * i][2] * sc_ * g0[2], yv[2 * i][3] * sc_ * g0[3]);
      w.z = cvtpk(yv[2 * i + 1][0] * sc_ * g1[0], yv[2 * i + 1][1] * sc_ * g1[1]); w.w = cvtpk(yv[2 * i + 1][2] * sc_ * g1[2], yv[2 * i + 1][3] * sc_ * g1[3]);
      *(u32x4*)(orow + 8 * i) = w; }
  }
  ATT_BAR();
#undef ATT_DMAK
#undef ATT_DMAV
#undef ATT_BAR
#undef ATT_BARV
}
}


namespace ret {
using att::bf16x8; using att::s16x4; using att::f32x16; using att::crow; using att::cvtpk;
constexpr int QP = 272, KP = 320, VP = 576, OP = 260;
constexpr int SZ_Q = 32 * QP, SZ_K = 32 * KP, SZ_V = 32 * VP, SZ_BUF = SZ_Q + SZ_K + SZ_V, R_OUT = 2 * SZ_BUF, R_GAIN = R_OUT + 32 * OP * 4, R_END = R_GAIN + 1024;
static_assert(SZ_BUF % 16 == 0 && R_OUT % 16 == 0, "LDS alignment");
__device__ __forceinline__ s16x4 trr(int addr) { return __builtin_bit_cast(s16x4, __builtin_amdgcn_ds_read_tr16_b64_v4i16((LAS att::v4i16_t*)(unsigned)addr)); }
#define RET_PK(L, H) (bf16x8){L[0], L[1], L[2], L[3], H[0], H[1], H[2], H[3]}
#define RET_PK4(P, BASE, OUT) do { unsigned a0 = cvtpk(P[BASE + 0], P[BASE + 1]), a1 = cvtpk(P[BASE + 2], P[BASE + 3]);   \
    unsigned b0 = cvtpk(P[BASE + 4], P[BASE + 5]), b1 = cvtpk(P[BASE + 6], P[BASE + 7]);                              \
    auto r0 = __builtin_amdgcn_permlane32_swap(a0, b0, false, false); auto r1 = __builtin_amdgcn_permlane32_swap(a1, b1, false, false); \
    u32x4 w_ = {r0[0], r1[0], r0[1], r1[1]}; OUT = __builtin_bit_cast(bf16x8, w_); } while (0)
__device__ __forceinline__ void ret_chain(LAS unsigned char* lds, const bf16* __restrict__ proj, bf16* __restrict__ yr, int b, int h, const float* __restrict__ gret) {
  int tid_ = threadIdx.x; asm volatile("" : "+v"(tid_));
  const int tid = tid_, w = __builtin_amdgcn_readfirstlane(tid >> 6), lane = tid & 63, r32 = lane & 31, hi = lane >> 5, g16 = (lane >> 4) & 1, i16 = lane & 15, q4 = i16 >> 2, p4 = i16 & 3;
  const size_t rowbase = (size_t)b * S;
  const float l2g = ret_log2gamma(h), gC = __builtin_amdgcn_exp2f(l2g * (float)RCH);
  const int srow = tid >> 4, sch = tid & 15;
  const bf16* qsrc = proj + (rowbase + srow) * PP + O_QR + h * 128 + sch * 8;
  const bf16* ksrc = proj + (rowbase + srow) * PP + O_KR + h * 128 + sch * 8;
  const bf16* vsrc = proj + (rowbase + srow) * PP + O_VR + h * 256 + sch * 8;
  const int qdst = srow * QP + sch * 16, kdst = SZ_Q + srow * KP + sch * 16, vdst = SZ_Q + SZ_K + srow * VP + sch * 16;
  const int ldsb = (int)(unsigned)(uintptr_t)lds;
  const int qrd = r32 * QP + hi * 16, krd = SZ_Q + r32 * KP + hi * 16;
  const int ktr = ldsb + SZ_Q + (8 * hi + q4) * KP + (16 * g16 + 4 * p4) * 2;
  const int vtr = ldsb + SZ_Q + SZ_K + (8 * hi + q4) * VP + (32 * w + 16 * g16 + 4 * p4) * 2;
  const int erow = tid >> 4, ec0 = (tid & 15) * 16;
  struct { bf16x8 q, k, v0, v1; } st;
#define RET_LOADS(i) do { const size_t ro_ = (size_t)(i) * RCH * PP; st.q = *(const bf16x8*)(qsrc + ro_); st.k = *(const bf16x8*)(ksrc + ro_); st.v0 = *(const bf16x8*)(vsrc + ro_); st.v1 = *(const bf16x8*)(vsrc + ro_ + 128); } while (0)
#define RET_WRITE(bf) do { LAS unsigned char* d_ = lds + (bf) * SZ_BUF; *(LAS bf16x8*)(d_ + qdst) = st.q; *(LAS bf16x8*)(d_ + kdst) = st.k; *(LAS bf16x8*)(d_ + vdst) = st.v0; *(LAS bf16x8*)(d_ + vdst + 256) = st.v1; } while (0)
  if (tid < 256) ((LAS float*)(lds + R_GAIN))[tid] = gret[h * 256 + tid];
  f32x16 R[4];
#pragma unroll
  for (int kb = 0; kb < 4; ++kb) R[kb] = f32x16{};
  float qd[16];
#pragma unroll
  for (int r = 0; r < 16; ++r) qd[r] = __builtin_amdgcn_exp2f(l2g * (float)(crow(r, hi) + 1));
  RET_LOADS(0); asm volatile("s_waitcnt vmcnt(0)" ::: "memory"); RET_WRITE(0); RET_LOADS(1);
  constexpr int NCH = S / RCH;
  for (int i = 0; i < NCH; ++i) {
    const int bf = i & 1;
    asm volatile("s_waitcnt lgkmcnt(0)\n\ts_barrier" ::: "memory");
    if (i + 1 < NCH) { RET_WRITE(bf ^ 1); if (i + 2 < NCH) RET_LOADS(i + 2); }
    const size_t erow_g = rowbase + (size_t)i * RCH + erow;
    const u32x4 gr0 = *(const u32x4*)(proj + erow_g * PP + O_GR + h * 256 + ec0), gr1 = *(const u32x4*)(proj + erow_g * PP + O_GR + h * 256 + ec0 + 8);
    const LAS unsigned char* B_ = lds + bf * SZ_BUF; const int boff = bf * SZ_BUF;
    bf16x8 qf[8]; f32x16 x = f32x16{};
#pragma unroll
    for (int s_ = 0; s_ < 8; ++s_) qf[s_] = *(const LAS bf16x8*)(B_ + qrd + 32 * s_);
    bf16x8 vf0, vf1;
    { const s16x4 l0 = trr(vtr + boff), h0 = trr(vtr + boff + 4 * VP), l1 = trr(vtr + boff + 16 * VP), h1 = trr(vtr + boff + 20 * VP);
      vf0 = RET_PK(l0, h0); vf1 = RET_PK(l1, h1); }
    { bf16x8 kf[8];
#pragma unroll
      for (int s_ = 0; s_ < 8; ++s_) kf[s_] = *(const LAS bf16x8*)(B_ + krd + 32 * s_);
      __builtin_amdgcn_sched_barrier(0);
#pragma unroll
      for (int s_ = 0; s_ < 8; ++s_) x = __builtin_amdgcn_mfma_f32_32x32x16_bf16(kf[s_], qf[s_], x, 0, 0, 0); }
#pragma unroll
    for (int r = 0; r < 16; ++r) x[r] = (crow(r, hi) <= r32) ? x[r] : 0.f;
    bf16x8 xa0, xa1; RET_PK4(x, 0, xa0); RET_PK4(x, 8, xa1);
    f32x16 o = __builtin_amdgcn_mfma_f32_32x32x16_bf16(xa0, vf0, f32x16{}, 0, 0, 0); o = __builtin_amdgcn_mfma_f32_32x32x16_bf16(xa1, vf1, o, 0, 0, 0);
#pragma unroll
    for (int kb = 0; kb < 4; ++kb) { bf16x8 rb0, rb1; RET_PK4(R[kb], 0, rb0); RET_PK4(R[kb], 8, rb1);
      o = __builtin_amdgcn_mfma_f32_32x32x16_bf16(qf[2 * kb], rb0, o, 0, 0, 0); o = __builtin_amdgcn_mfma_f32_32x32x16_bf16(qf[2 * kb + 1], rb1, o, 0, 0, 0); }
#pragma unroll
    for (int kb = 0; kb < 4; ++kb) {
      const s16x4 l0 = trr(ktr + boff + 64 * kb), h0 = trr(ktr + boff + 64 * kb + 4 * KP), l1 = trr(ktr + boff + 64 * kb + 16 * KP), h1 = trr(ktr + boff + 64 * kb + 20 * KP);
      R[kb] = __builtin_amdgcn_mfma_f32_32x32x16_bf16(RET_PK(l0, h0), vf0, R[kb], 0, 0, 0); R[kb] = __builtin_amdgcn_mfma_f32_32x32x16_bf16(RET_PK(l1, h1), vf1, R[kb], 0, 0, 0);
#pragma unroll
      for (int r = 0; r < 16; ++r) R[kb][r] *= gC; }
    LAS float* OUT = (LAS float*)(lds + R_OUT);
#pragma unroll
    for (int r = 0; r < 16; ++r) OUT[crow(r, hi) * OP + 32 * w + r32] = o[r] * qd[r];
    asm volatile("s_waitcnt lgkmcnt(0)\n\ts_barrier" ::: "memory");
    { const LAS f32x4* orow = (const LAS f32x4*)(OUT + erow * OP + ec0); f32x4 v[4]; float ssq = 0.f;
#pragma unroll
      for (int k = 0; k < 4; ++k) { v[k] = orow[k]; ssq += (v[k][0] * v[k][0] + v[k][1] * v[k][1]) + (v[k][2] * v[k][2] + v[k][3] * v[k][3]); }
      ssq += __shfl_xor(ssq, 1); ssq += __shfl_xor(ssq, 2); ssq += __shfl_xor(ssq, 4); ssq += __shfl_xor(ssq, 8);
      const float rstd = rsqrtf(ssq * (1.f / 256.f) + EPS);
      f32x4 a0, a1, a2, a3; pg8::unpack8(gr0, a0, a1); pg8::unpack8(gr1, a2, a3);
      f32x4 gate[4] = {a0, a1, a2, a3};
#pragma unroll
      for (int k = 0; k < 4; ++k) { const f32x4 gg = *(const LAS f32x4*)(lds + R_GAIN + (ec0 + 4 * k) * 4);
#pragma unroll
        for (int e = 0; e < 4; ++e) v[k][e] = v[k][e] * rstd * gg[e] * (gate[k][e] * sigmoidf_(gate[k][e])); }
      bf16* dst = yr + erow_g * PP + h * 256 + ec0;
      *(u32x4*)dst = pg8::pack8(v[0], v[1]); *(u32x4*)(dst + 8) = pg8::pack8(v[2], v[3]); }
  }
  asm volatile("s_waitcnt lgkmcnt(0)\n\ts_barrier" ::: "memory");
#undef RET_LOADS
#undef RET_WRITE
}
#undef RET_PK
#undef RET_PK4
}

struct LamPtrs { const float* q1; const float* k1; const float* q2; const float* k2; };
__device__ __forceinline__ float compute_lam(const LamPtrs& L, int lane) {
    const float a = wave_sum(L.q1[lane] * L.k1[lane]), b = wave_sum(L.q2[lane] * L.k2[lane]);
    return __expf(a) - __expf(b) + LAM_INIT;
}

#define XB_TMO      128
#define XB_XCNT(j)  (256  + 64 * (j))
#define XB_XSUB(j)  (1280 + 64 * (j))
#define XB_XGEN(j)  (2304 + 64 * (j))
#define XB_TOP      3328
#define XB_TOPGEN   3392
#define XCD_BAR_WORDS 3456
#define XB_SPIN_CAP (1u << 23)
__device__ __forceinline__ unsigned xb_ld(unsigned* p)              { return __hip_atomic_load(p, __ATOMIC_RELAXED, __HIP_MEMORY_SCOPE_AGENT); }
__device__ __forceinline__ unsigned xb_add(unsigned* p, unsigned v) { return __hip_atomic_fetch_add(p, v, __ATOMIC_RELAXED, __HIP_MEMORY_SCOPE_AGENT); }
__device__ __forceinline__ unsigned xb_xcc_id() { return (unsigned)__builtin_amdgcn_s_getreg((3 << 11) | 20) & 0xFu; }
#define XB_SPIN(cond, bar) do { unsigned _sp = 0; while (cond) { __builtin_amdgcn_s_sleep(1); \
    if ((++_sp & 255u) == 0u) { if (xb_ld(&(bar)[XB_TMO])) break; if (_sp > XB_SPIN_CAP) { atomicAdd(&(bar)[XB_TMO], 1u); break; } } } } while (0)
struct XcdBarrier { unsigned* bar; unsigned x; volatile LAS unsigned* st; };
__device__ __forceinline__ XcdBarrier xcd_barrier_post(unsigned* bar, volatile LAS unsigned* st) {
    XcdBarrier b; b.bar = bar; b.x = xb_xcc_id(); b.st = st;
    if (threadIdx.x == 0) (void)xb_add(&bar[XB_XCNT(b.x)], 1u);
    return b;
}
__device__ __forceinline__ void xcd_barrier_complete(unsigned* bar, unsigned x, unsigned& nloc, unsigned& nx) {
    const unsigned G = gridDim.x * gridDim.y * gridDim.z;
    unsigned sum, cnt, mine, sp = 0u;
    for (;;) {
        sum = 0u; cnt = 0u; mine = 0u;
#pragma unroll
        for (unsigned j = 0; j < 16; ++j) { const unsigned c = xb_ld(&bar[XB_XCNT(j)]); sum += c; cnt += (c > 0u) ? 1u : 0u; mine = (j == x) ? c : mine; }
        if (sum == G) break;
        __builtin_amdgcn_s_sleep(1);
        if ((++sp & 255u) == 0u) { if (xb_ld(&bar[XB_TMO])) break; if (sp > XB_SPIN_CAP) { atomicAdd(&bar[XB_TMO], 1u); break; } }
    }
    nloc = mine > 0u ? mine : 1u; nx = cnt > 0u ? cnt : 1u;
}
__device__ __forceinline__ void xcd_barrier(const XcdBarrier& b) {
    asm volatile("s_waitcnt vmcnt(0)" ::: "memory");
    __syncthreads();
    if (threadIdx.x == 0) {
        unsigned* bar = b.bar;
        __builtin_amdgcn_s_waitcnt(0);
        unsigned nloc = b.st[0], nx = b.st[1];
        if (nloc == 0u) { xcd_barrier_complete(bar, b.x, nloc, nx); b.st[0] = nloc; b.st[1] = nx; }
        const unsigned old = xb_add(&bar[XB_XSUB(b.x)], 1u);
        const unsigned gen = old / nloc;
        if (old + 1u == (gen + 1u) * nloc) {
            __builtin_amdgcn_fence(__ATOMIC_RELEASE, "agent");
            asm volatile("s_waitcnt vmcnt(0)" ::: "memory");
            const unsigned og = xb_add(&bar[XB_TOP], 1u);
            const unsigned tg = og / nx;
            if (og + 1u == (tg + 1u) * nx) xb_add(&bar[XB_TOPGEN], 1u);
            else XB_SPIN(xb_ld(&bar[XB_TOPGEN]) == tg, bar);
            __builtin_amdgcn_fence(__ATOMIC_ACQUIRE, "agent");
            xb_add(&bar[XB_XGEN(b.x)], 1u);
            asm volatile("s_waitcnt vmcnt(0)" ::: "memory");
        } else {
            XB_SPIN(xb_ld(&bar[XB_XGEN(b.x)]) == gen, bar);
            __builtin_amdgcn_fence(__ATOMIC_ACQUIRE, "agent");
            asm volatile("s_waitcnt vmcnt(0)" ::: "memory");
        }
    }
    __syncthreads();
}

constexpr int NWAVES = 8;
constexpr int LDS_BYTES = 147456, LDSCTL_OFF = LDS_BYTES - 1024, MISC_OFF = LDSCTL_OFF + 320;
static_assert(att::A_G + 512 <= LDSCTL_OFF && att::A_END <= att::A_G && ret::R_END <= att::A_G && 7 * 16384 + 8448 <= att::A_G && pg8::STAGE_BYTES <= LDSCTL_OFF && ret::R_END <= LDSCTL_OFF, "LDS map");
constexpr int CW_QUEUE = 16384;
constexpr int N_PHASES = 10;

struct P0Item { const float* W; const float* gain; bf16* WT; int N, ldt, k0, n0; };
__device__ __forceinline__ void p0_load(const P0Item& I, int lane, f32x4 (&v)[10]) {
    const int c = lane & 7;
    const float* gp = I.gain ? I.gain + I.k0 + 8 * c : I.W;
    v[8] = *(const f32x4*)gp; v[9] = *(const f32x4*)(gp + 4);
#pragma unroll
    for (int i = 0; i < 8; ++i) v[i] = *(const f32x4*)(I.W + (size_t)(I.k0 + 8 * i + (lane >> 3)) * I.N + I.n0 + 4 * c);
}
__device__ __forceinline__ void p0_store(const P0Item& I, int lane, const f32x4 (&v)[10], LAS float* scr) {
    const int c = lane & 7;
    const f32x4 one = {1.f, 1.f, 1.f, 1.f}; const f32x4 g0 = I.gain ? v[8] : one, g1 = I.gain ? v[9] : one;
#pragma unroll
    for (int i = 0; i < 8; ++i) { LAS float* d = scr + (8 * i + (lane >> 3)) * 33 + 4 * c; d[0] = v[i].x; d[1] = v[i].y; d[2] = v[i].z; d[3] = v[i].w; }
    LDS_WAIT(); asm volatile("" ::: "memory");
#pragma unroll
    for (int j = 0; j < 4; ++j) { const int n = (lane >> 3) + 8 * j; const LAS float* s = scr + (8 * c) * 33 + n;
        u32x4 o; o.x = pk2(s[0 * 33] * g0.x, s[1 * 33] * g0.y); o.y = pk2(s[2 * 33] * g0.z, s[3 * 33] * g0.w); o.z = pk2(s[4 * 33] * g1.x, s[5 * 33] * g1.y); o.w = pk2(s[6 * 33] * g1.z, s[7 * 33] * g1.w);
        *(u32x4*)(I.WT + (size_t)(I.n0 + n) * I.ldt + I.k0 + 8 * c) = o; }
    LDS_WAIT(); asm volatile("" ::: "memory");
}
template <int NR> __device__ __forceinline__ void prep_rows(const float* __restrict__ xrow, const float* __restrict__ g, bf16* __restrict__ xnrow, const float* __restrict__ prow, bf16* __restrict__ pbrow, int lane) {
    f32x4 v[NR][4], pv[NR];
#pragma unroll
    for (int r = 0; r < NR; ++r) {
#pragma unroll
        for (int j = 0; j < 4; ++j) v[r][j] = ((const f32x4*)(xrow + (size_t)r * D))[lane + 64 * j];
        pv[r] = ((const f32x4*)(prow + (size_t)r * PLE))[lane]; }
    f32x4 gg[4];
#pragma unroll
    for (int j = 0; j < 4; ++j) gg[j] = ((const f32x4*)g)[lane + 64 * j];
#pragma unroll
    for (int r = 0; r < NR; ++r) { float s = 0.f;
#pragma unroll
        for (int j = 0; j < 4; ++j) s += pg8::sumsq4(v[r][j]);
        const float rstd = rsqrtf(wave_sum(s) * (1.f / D) + EPS);
        u32x2* o = (u32x2*)(xnrow + (size_t)r * D) + lane;
#pragma unroll
        for (int j = 0; j < 4; ++j) { u32x2 w; w.x = pk2(v[r][j].x * rstd * gg[j].x, v[r][j].y * rstd * gg[j].y); w.y = pk2(v[r][j].z * rstd * gg[j].z, v[r][j].w * rstd * gg[j].w); o[64 * j] = w; }
        u32x2 w; w.x = pk2(pv[r].x, pv[r].y); w.y = pk2(pv[r].z, pv[r].w); ((u32x2*)(pbrow + (size_t)r * D))[lane] = w; }
}
template <int NR> __device__ __forceinline__ void final_rows(const bf16* __restrict__ x3row, float* __restrict__ orow, const float* __restrict__ ss, const float* __restrict__ g, int row, int lane) {
    u32x4 xv[NR][2]; float sq[NR];
#pragma unroll
    for (int r = 0; r < NR; ++r) { sq[r] = ss[(size_t)(row + r) * 16 + (lane & 15)];
#pragma unroll
        for (int j = 0; j < 2; ++j) xv[r][j] = ((const u32x4*)(x3row + (size_t)r * D))[lane + 64 * j]; }
    f32x4 gg[4];
#pragma unroll
    for (int j = 0; j < 2; ++j) { gg[2 * j] = ((const f32x4*)g)[2 * lane + 128 * j]; gg[2 * j + 1] = ((const f32x4*)g)[2 * lane + 128 * j + 1]; }
#pragma unroll
    for (int r = 0; r < NR; ++r) { float q = sq[r];
        q += __shfl_xor(q, 1); q += __shfl_xor(q, 2); q += __shfl_xor(q, 4); q += __shfl_xor(q, 8);
        const float rstd = rsqrtf(q * (1.f / D) + EPS);
        f32x4* o = (f32x4*)(orow + (size_t)r * D) + 2 * lane;
#pragma unroll
        for (int j = 0; j < 2; ++j) { f32x4 v0, v1; pg8::unpack8(xv[r][j], v0, v1); o[128 * j] = v0 * rstd * gg[2 * j]; o[128 * j + 1] = v1 * rstd * gg[2 * j + 1]; } }
}

struct Args { const float* in[20]; float* out; unsigned char* ws; int ph_lo, ph_hi; };
typedef const __attribute__((address_space(4))) Args* KArgs;
__device__ __forceinline__ KArgs kargs() { KArgs p = (KArgs)__builtin_amdgcn_kernarg_segment_ptr(); asm volatile("" : "+s"(p)); return p; }
#if MK_PER_PHASE
#define IN(k) (ka->ph_lo <= (k) && (k) < ka->ph_hi)
#define GRID_BAR(k) do { } while (0)
#else
#define IN(k) true
#define GRID_BAR(k) do { if ((k) + 1 < N_PHASES) { XcdBarrier b_; b_.bar = (unsigned*)(ka->ws + WS_CTL) + CW_BAR; b_.x = xb_xcc_id(); b_.st = (volatile LAS unsigned*)(lds + MISC_OFF) + 8; xcd_barrier(b_); } } while (0)
#endif
#define WSPTRS(wsb) \
    bf16 *WIN = (bf16*)((wsb) + WS_WIN), *WBD = (bf16*)((wsb) + WS_WBD), *WBR = (bf16*)((wsb) + WS_WBR), *WOUT = (bf16*)((wsb) + WS_WOUT), *W1 = (bf16*)((wsb) + WS_W1), *W2 = (bf16*)((wsb) + WS_W2), *WPG = (bf16*)((wsb) + WS_WPG), *WPLE = (bf16*)((wsb) + WS_WPLE); \
    float* SS1 = (float*)((wsb) + WS_SS); float* SS2 = SS1 + (size_t)MG * 16; float* SS3 = SS2 + (size_t)MG * 16; \
    bf16 *XN = (bf16*)ka->out, *PB = (bf16*)ka->out + (size_t)M * D, *MIX = (bf16*)((wsb) + WS_MIX), *PROJ = (bf16*)((wsb) + WS_PROJ), *HID = (bf16*)((wsb) + WS_PROJ); \
    bf16 *YA = PROJ + O_QA, *YR = PROJ + O_VR; \
    (void)WIN; (void)WBD; (void)WBR; (void)WOUT; (void)W1; (void)W2; (void)WPG; (void)WPLE; (void)SS1; (void)SS2; (void)SS3; (void)PB; (void)XN; (void)YA; (void)YR; (void)MIX; (void)PROJ; (void)HID
#define LANEINFO() int tid_ = threadIdx.x; asm volatile("" : "+v"(tid_)); const int tid = tid_, lane = tid & 63, wave = __builtin_amdgcn_readfirstlane(tid >> 6), G = gridDim.x, gw = (int)blockIdx.x * NWAVES + wave, NGW = G * NWAVES; (void)lane; (void)gw; (void)NGW; (void)G

__global__ void __launch_bounds__(NWAVES * 64, 2) mk_fwd(Args args_unused) {
    extern __shared__ __attribute__((aligned(16))) unsigned char lds_raw[];
    LAS unsigned char* lds = (LAS unsigned char*)lds_raw;
    for (int u = threadIdx.x; u < (LDS_BYTES - LDSCTL_OFF) / 4; u += NWAVES * 64) ((LAS unsigned*)(lds + LDSCTL_OFF))[u] = 0u;
    __syncthreads();
    if (!MK_PER_PHASE) { KArgs ka = kargs(); (void)xcd_barrier_post((unsigned*)(ka->ws + WS_CTL) + CW_BAR, (volatile LAS unsigned*)(lds + MISC_OFF) + 8); }

    { KArgs ka = kargs();
    if (IN(0)) {
        LANEINFO(); unsigned char* ws = ka->ws; WSPTRS(ws);
        LAS float* scr = (LAS float*)(lds + wave * 16384);
        constexpr int I_IN = (D / 64) * (DIN / 32), I_SQ = (D / 64) * (D / 32), I_1 = (D / 64) * (FF / 32), I_2 = (FF / 64) * (D / 32), I_PL = (PLE / 64) * (D / 32);
        constexpr int NITEMS = I_IN + 4 * I_SQ + I_1 + I_2 + I_PL;
        auto decode = [&](int it) { P0Item I; int r = it, sh;
            if (r < I_IN) { I.W = ka->in[3]; I.gain = nullptr; I.WT = WIN; I.N = DIN; I.ldt = D; sh = 8; }
            else if ((r -= I_IN) < I_SQ) { I.W = ka->in[10]; I.gain = nullptr; I.WT = WBD; I.N = D; I.ldt = D; sh = 5; }
            else if ((r -= I_SQ) < I_SQ) { I.W = ka->in[11]; I.gain = nullptr; I.WT = WBR; I.N = D; I.ldt = D; sh = 5; }
            else if ((r -= I_SQ) < I_SQ) { I.W = ka->in[12]; I.gain = nullptr; I.WT = WOUT; I.N = D; I.ldt = D; sh = 5; }
            else if ((r -= I_SQ) < I_SQ) { I.W = ka->in[17]; I.gain = ka->in[16]; I.WT = WPG; I.N = D; I.ldt = D; sh = 5; }
            else if ((r -= I_SQ) < I_1) { I.W = ka->in[14]; I.gain = ka->in[13]; I.WT = W1; I.N = FF; I.ldt = D; sh = 7; }
            else if ((r -= I_1) < I_2) { I.W = ka->in[15]; I.gain = nullptr; I.WT = W2; I.N = D; I.ldt = FF; sh = 5; }
            else { r -= I_2; I.W = ka->in[18]; I.gain = nullptr; I.WT = WPLE; I.N = D; I.ldt = D; sh = 5; }
            I.k0 = 64 * (r >> sh); I.n0 = 32 * (r & ((1 << sh) - 1)); return I; };
        { int it = gw; P0Item I{}; f32x4 cur[10], nxt[10];
          if (it < NITEMS) { I = decode(it); p0_load(I, lane, cur); }
          for (; it + NGW < NITEMS; it += NGW) {
              const P0Item In = decode(it + NGW); p0_load(In, lane, nxt);
              p0_store(I, lane, cur, scr);
              I = In;
#pragma unroll
              for (int i = 0; i < 10; ++i) cur[i] = nxt[i]; }
          if (it < NITEMS) p0_store(I, lane, cur, scr); }
        const float* x = ka->in[0]; const float* p = ka->in[1]; const float* g_mix = ka->in[2];
        for (int m = gw * 4; m < M; m += NGW * 4) prep_rows<4>(x + (size_t)m * D, g_mix, XN + (size_t)m * D, p + (size_t)m * PLE, PB + (size_t)m * D, lane);
        GRID_BAR(0);
    } }
    { KArgs ka = kargs();
    if (IN(1)) {
        unsigned char* ws = ka->ws; WSPTRS(ws);
        pg8::Gemm gm{XN, WIN, XN, WIN, D, D, D, D}; pg8::StaticOrder So; So.init(M, PP, gridDim.x, (int)blockIdx.x, 1);
        pg8::EpiProj E{PROJ};
        pg8::gemm_phase<pg8::EpiProj, true>(lds, gm, So, E);
        GRID_BAR(1);
    } }
    { KArgs ka = kargs();
    if (IN(2)) {
        LANEINFO(); unsigned char* ws = ka->ws; WSPTRS(ws);
        const LamPtrs L{ka->in[4], ka->in[5], ka->in[6], ka->in[7]};
        const float lam = __builtin_bit_cast(float, __builtin_amdgcn_readfirstlane(__builtin_bit_cast(int, compute_lam(L, lane)))); const float* g_diff = ka->in[8]; const float* g_ret = ka->in[9];
        { unsigned* qhead = (unsigned*)(ws + WS_CTL) + CW_QUEUE; volatile LAS unsigned* slot = (volatile LAS unsigned*)(lds + MISC_OFF) + 16;
          constexpr int NCHAINS = NB * 4, NATT = NB * 8 * 16, NUNITS = NCHAINS + NATT;
          if (tid < 128) ((LAS float*)(lds + att::A_G))[tid] = g_diff[tid] * (1.f - LAM_INIT);
          unsigned nxt_ = 0u; if (tid == 0) nxt_ = __hip_atomic_fetch_add(qhead, 1u, __ATOMIC_RELAXED, __HIP_MEMORY_SCOPE_AGENT);
          for (int n_ = 0;; ++n_) {
              if (tid == 0) { slot[n_ & 1] = nxt_; }
              asm volatile("s_waitcnt lgkmcnt(0)\n\ts_barrier" ::: "memory"); const int item = (int)slot[n_ & 1];
              if (tid == 0) nxt_ = __hip_atomic_fetch_add(qhead, 1u, __ATOMIC_RELAXED, __HIP_MEMORY_SCOPE_AGENT);
              if (item >= NUNITS) break;
              if (item < NCHAINS) { ret::ret_chain(lds, PROJ, YR, item >> 2, item & 3, g_ret); continue; }
              const int a_ = item - NCHAINS, r_ = a_ & 1023, bh = r_ >> 2, qb = 4 * (3 - (a_ >> 10)) + 3 - (r_ & 3);
              att::attn_unit(lds, PROJ, YA, bh >> 3, bh & 7, qb, lam, g_diff);
          } }
        GRID_BAR(2);
    } }
    { KArgs ka = kargs();
    if (IN(3)) {
        unsigned char* ws = ka->ws; WSPTRS(ws);
        const bf16* WG = WIN + (size_t)W_GATE_ROW * D;
        pg8::Gemm gm{XN, WG, XN, WG, D, D, D, D}; pg8::StaticOrder So; So.init(M, 2 * D, gridDim.x, (int)blockIdx.x, 1);
        pg8::EpiGate E{PROJ + O_GA};
        pg8::gemm_phase<pg8::EpiGate, true>(lds, gm, So, E);
        GRID_BAR(3);
    } }
    { KArgs ka = kargs();
    if (IN(4)) {
        unsigned char* ws = ka->ws; WSPTRS(ws);
        pg8::Gemm gm{YA, WBD, YR, WBR, PP, D, D, D}; pg8::StaticOrder So; So.init(M, D, gridDim.x, (int)blockIdx.x, 2);
        pg8::EpiMix E{PROJ, MIX};
        pg8::gemm_phase<pg8::EpiMix, true>(lds, gm, So, E);
        GRID_BAR(4);
    } }
    { KArgs ka = kargs();
    if (IN(5)) {
        unsigned char* ws = ka->ws; WSPTRS(ws);
        pg8::Gemm gm{MIX, WOUT, MIX, WOUT, D, D, D, D}; pg8::StaticOrder So; So.init(M, D, gridDim.x, (int)blockIdx.x, 1);
        pg8::EpiRes<false> E{ka->in[0], XN, SS1};
        pg8::gemm_phase<pg8::EpiRes<false>, true>(lds, gm, So, E);
        GRID_BAR(5);
    } }
    { KArgs ka = kargs();
    if (IN(6)) {
        unsigned char* ws = ka->ws; WSPTRS(ws);
        pg8::Gemm gm{XN, W1, XN, W1, D, D, D, D}; pg8::StaticOrder So; So.init(M, FF, gridDim.x, (int)blockIdx.x, 1);
        pg8::EpiHid E{SS1, HID};
        pg8::gemm_phase<pg8::EpiHid, true>(lds, gm, So, E);
        GRID_BAR(6);
    } }
    { KArgs ka = kargs();
    if (IN(7)) {
        unsigned char* ws = ka->ws; WSPTRS(ws);
        pg8::Gemm gm{HID, W2, HID, W2, FF, FF, FF, FF}; pg8::StaticOrder So; So.init(M, D, gridDim.x, (int)blockIdx.x, 1);
        pg8::EpiRes<true> E{nullptr, XN, SS2};
        pg8::gemm_phase<pg8::EpiRes<true>, true>(lds, gm, So, E);
        GRID_BAR(7);
    } }
    { KArgs ka = kargs();
    if (IN(8)) {
        unsigned char* ws = ka->ws; WSPTRS(ws);
        pg8::Gemm gm{PB, WPLE, XN, WPG, D, D, PLE, D}; pg8::StaticOrder So; So.init(M, D, gridDim.x, (int)blockIdx.x, 2);
        pg8::EpiPle E{SS2, MIX, XN, SS3};
        pg8::gemm_phase<pg8::EpiPle, true>(lds, gm, So, E);
        GRID_BAR(8);
    } }
    { KArgs ka = kargs();
    if (IN(9)) {
        LANEINFO(); unsigned char* ws = ka->ws; WSPTRS(ws);
        float* og = ka->out; const float* g_final = ka->in[19];
        for (int m = gw * 4; m < M; m += NGW * 4) final_rows<4>(MIX + (size_t)m * D, og + (size_t)m * D, SS3, g_final, m, lane);
    } }
}

extern "C" void kernel_launch(void* const* d_in, const int* in_sizes, int n_in, void* d_out, int out_size, void* d_ws, size_t ws_size, hipStream_t stream) {
    static int grid = 0;
    if (grid == 0) {
        if (n_in != 20 || in_sizes[0] != M * D || out_size != M * D || ws_size < WS_END) { fprintf(stderr, "kernel_launch: unexpected shapes (n_in %d, ws %zu)\n", n_in, ws_size); grid = -1; return; }
        int dev = 0, cus = 0, per_cu = 0;
        if (hipGetDevice(&dev) != hipSuccess || hipDeviceGetAttribute(&cus, hipDeviceAttributeMultiprocessorCount, dev) != hipSuccess) { grid = -1; return; }
        if (hipFuncSetAttribute((const void*)mk_fwd, hipFuncAttributeMaxDynamicSharedMemorySize, LDS_BYTES) != hipSuccess) { fprintf(stderr, "kernel_launch: hipFuncSetAttribute failed\n"); grid = -1; return; }
        if (hipOccupancyMaxActiveBlocksPerMultiprocessor(&per_cu, (const void*)mk_fwd, NWAVES * 64, LDS_BYTES) != hipSuccess || per_cu < 1) { fprintf(stderr, "kernel_launch: occupancy query says %d\n", per_cu); (void)hipGetLastError(); grid = -1; return; }
        grid = cus;
    }
    if (grid < 0) return;
    if (hipMemsetAsync((char*)d_ws + WS_CTL, 0, CTL_ZERO_BYTES, stream) != hipSuccess) return;
    Args a{};
    for (int i = 0; i < 20; ++i) a.in[i] = (const float*)d_in[i];
    a.out = (float*)d_out; a.ws = (unsigned char*)d_ws;
#if MK_PER_PHASE
    for (int ph = 0; ph < N_PHASES; ++ph) { a.ph_lo = ph; a.ph_hi = ph + 1; hipLaunchKernelGGL(mk_fwd, dim3(grid), dim3(NWAVES * 64), LDS_BYTES, stream, a); }
#else
    a.ph_lo = 0; a.ph_hi = N_PHASES;
    hipLaunchKernelGGL(mk_fwd, dim3(grid), dim3(NWAVES * 64), LDS_BYTES, stream, a);
#endif
}
```

```cpp
#include <hip/hip_runtime.h>
#include <cstdint>
#include <cstdio>

#ifndef MK_PER_PHASE
#define MK_PER_PHASE 0
#endif

typedef unsigned short bf16;
typedef unsigned u32x4 __attribute__((ext_vector_type(4)));
typedef unsigned u32x2 __attribute__((ext_vector_type(2)));
typedef float f32x4 __attribute__((ext_vector_type(4)));
typedef float f32x2 __attribute__((ext_vector_type(2)));
#define LAS __attribute__((address_space(3)))
#define GAS __attribute__((address_space(1)))

constexpr int D = 1024, NB = 32, S = 2048, PLE = 256, DIN = 8192, FF = 4096, M = NB * S;
constexpr int MG = M;
constexpr int PP = 6144;
constexpr float EPS = 1e-6f;
constexpr int O_QA = 0, O_KA = 1024, O_VA = 2048, O_QR = 3072, O_KR = 3584, O_VR = 4096, O_GR = 5120, O_GA = 1024, O_GB = 2048;
constexpr int W_GATE_ROW = 6144;
constexpr float LOG2E = 1.4426950408889634f;
constexpr float QA_SCALE = 0.125f * LOG2E;
constexpr float KR_SCALE = 0.08838834764831845f;
constexpr int RCH = 32;
constexpr float LAM_INIT = 0.2f;

constexpr size_t MiB = 1u << 20;
constexpr size_t WS_CTL = 0, CTL_ZERO_BYTES = 128 * 1024;
constexpr size_t WS_WIN = 1 * MiB, WS_WBD = 17 * MiB, WS_WBR = 19 * MiB, WS_WOUT = 21 * MiB, WS_W1 = 23 * MiB, WS_W2 = 31 * MiB, WS_WPG = 39 * MiB, WS_WPLE = 41 * MiB;
constexpr size_t WS_SS = 44 * MiB;
constexpr size_t WS_MIX = 56 * MiB;
constexpr size_t WS_PROJ = 184 * MiB;
constexpr size_t WS_END = 952 * MiB;
constexpr int CW_BAR = 4096;

__device__ __forceinline__ float bf2f(bf16 v) { return __uint_as_float((unsigned)v << 16); }
__device__ __forceinline__ bf16 f2bf(float f) { unsigned u = __float_as_uint(f); return (bf16)((u + 0x7fffu + ((u >> 16) & 1u)) >> 16); }
__device__ __forceinline__ unsigned pk2(float lo, float hi) { return (unsigned)f2bf(lo) | ((unsigned)f2bf(hi) << 16); }
__device__ __forceinline__ float wave_sum(float v) {
#pragma unroll
    for (int o = 1; o < 64; o <<= 1) v += __shfl_xor(v, o);
    return v;
}
__device__ __forceinline__ float wave_max(float v) {
#pragma unroll
    for (int o = 1; o < 64; o <<= 1) v = fmaxf(v, __shfl_xor(v, o));
    return v;
}
__device__ __forceinline__ float sum_fq(float v) {
    { auto r = __builtin_amdgcn_permlane16_swap(__float_as_uint(v), __float_as_uint(v), false, false); v = __uint_as_float(r[0]) + __uint_as_float(r[1]); }
    { auto r = __builtin_amdgcn_permlane32_swap(__float_as_uint(v), __float_as_uint(v), false, false); v = __uint_as_float(r[0]) + __uint_as_float(r[1]); }
    return v; }
__device__ __forceinline__ float sigmoidf_(float v) { return __builtin_amdgcn_rcpf(1.f + __builtin_amdgcn_exp2f(-v * LOG2E)); }
__device__ __forceinline__ float ret_log2gamma(int h) { return h == 0 ? -0.04580368961312479f : h == 1 ? -0.02272007650008353f : h == 2 ? -0.011315313227834146f : -0.005646563141142063f; }
#define LDS_WAIT() asm volatile("s_waitcnt lgkmcnt(0)" ::: "memory")

namespace pg8 {
#define PG8_LAS __attribute__((address_space(3)))
typedef unsigned short bf16_t;
typedef short bf16x8 __attribute__((ext_vector_type(8)));
constexpr int BM = 256, BK = 64, HALF = 128, HTB = HALF * BK * 2, STAGE_BYTES = 8 * HTB, NXCD = 8, WGM = 8;
__host__ __device__ __forceinline__ int lds_byte(int r, int c) { const int st = (r >> 4) * 2 + (c >> 5), rr = r & 15, cc = c & 31, ob = rr * 64 + cc * 2; return st * 1024 + (ob ^ (((ob >> 9) & 1) << 5)); }
__host__ __device__ __forceinline__ void stage_rc(int b, int& R, int& C) { const int st = b / 1024, sb = b % 1024, swz = sb ^ (((sb >> 9) & 1) << 5); R = (st >> 1) * 16 + swz / 64; C = (st & 1) * 32 + (swz % 64) / 2; }
__host__ __device__ __forceinline__ int perm32(int rho) { const int n = rho >> 4, i = rho & 15; return 8 * (i >> 2) + 4 * n + (i & 3); }

struct Unit { int pm, pn, z; };
struct Gemm { const bf16_t* A0; const bf16_t* B0; const bf16_t* A1; const bf16_t* B1; int lda, ldb, K0, K1; };

struct StaticOrder {
    int nM, nN, nwg, G, c, nz;
    __host__ __device__ void init(int M_, int N_, int G_, int c_, int nz_) { nM = M_ / BM; nN = N_ / BM; nwg = nM * nN; G = G_; c = c_; nz = nz_; }
    __host__ __device__ bool next(int i, Unit& u) const {
        const int ti = i / nz; u.z = i - ti * nz;
        const long L = (long)ti * G + c; if (L >= nwg) return false;
        int wgid = (int)L; { const int q = nwg / NXCD, r = nwg % NXCD, xcd = wgid % NXCD, off = wgid / NXCD; wgid = (xcd < r ? xcd * (q + 1) : r * (q + 1) + (xcd - r) * q) + off; }
        const int nig = WGM * nN, gid = wgid / nig, fm = gid * WGM, gsz = (nM - fm) < WGM ? (nM - fm) : WGM;
        u.pm = fm + ((wgid % nig) % gsz); u.pn = (wgid % nig) / gsz; return true;
    }
};
__device__ __forceinline__ unsigned cvt_pk_bf16(float lo, float hi) { unsigned r; asm volatile("v_cvt_pk_bf16_f32 %0, %1, %2" : "=v"(r) : "v"(lo), "v"(hi)); return r; }

template <class Epi, bool ALIGN_EPI>
__device__ __forceinline__ void gemm_phase(PG8_LAS unsigned char* lds, const Gemm g, const StaticOrder& S, const Epi& E) {
    int tid_ = threadIdx.x; asm volatile("" : "+v"(tid_));
    const int tid = tid_, wid = __builtin_amdgcn_readfirstlane(tid >> 6), lane = tid & 63, wr = wid >> 2, wc = wid & 3, fr = lane & 15, fq = lane >> 4;
    unsigned voffA[2], voffB[2];
#pragma unroll
    for (int i = 0; i < 2; ++i) { int R, C; stage_rc(tid * 16 + i * 8192, R, C); const int Rb = Epi::PERM ? ((R & ~31) + perm32(R & 31)) : R;
        voffA[i] = (unsigned)(R * g.lda + C) * 2u; voffB[i] = (unsigned)(Rb * g.ldb + C) * 2u; }
    const size_t kstep = (size_t)(BK * 2);
    const size_t hstepA = (size_t)HALF * g.lda * 2, hstepB = (size_t)HALF * g.ldb * 2;
    const size_t tstepA = 2 * hstepA, tstepB = 2 * hstepB;
    const unsigned ldsw = (unsigned)wid * 1024u;
    const int aoff = lds_byte(wr * 64 + fr, fq * 8), boff = lds_byte(wc * 32 + fr, fq * 8);
#define PG8_SA(b, h) (((b) * 2 + (h)) * HTB)
#define PG8_SB(b, h) ((4 + (b) * 2 + (h)) * HTB)
#define PG8_STAGE(bufoff, gbase, voff) do { _Pragma("unroll") for (int _i = 0; _i < 2; ++_i) \
        __builtin_amdgcn_global_load_lds((const unsigned*)((const char*)(gbase) + (voff)[_i]), (PG8_LAS unsigned*)(lds + (bufoff) + ldsw + _i * 8192), 16, 0, 0); } while (0)
#define PG8_LDA(dst, b, h) do { _Pragma("unroll") for (int m = 0; m < 4; ++m) _Pragma("unroll") for (int k = 0; k < 2; ++k) dst[m][k] = *(const PG8_LAS bf16x8*)(lds + PG8_SA(b, h) + aoff + m * 2048 + k * 1024); } while (0)
#define PG8_LDB(dst, b, h) do { _Pragma("unroll") for (int n = 0; n < 2; ++n) _Pragma("unroll") for (int k = 0; k < 2; ++k) dst[n][k] = *(const PG8_LAS bf16x8*)(lds + PG8_SB(b, h) + boff + n * 2048 + k * 1024); } while (0)
#define PG8_MMA(ai, bj, At, Bt) do { __builtin_amdgcn_s_setprio(1); _Pragma("unroll") for (int m = 0; m < 4; ++m) _Pragma("unroll") for (int n = 0; n < 2; ++n) _Pragma("unroll") for (int k = 0; k < 2; ++k) \
        acc[ai][bj][m][n] = __builtin_amdgcn_mfma_f32_16x16x32_bf16(Bt[n][k], At[m][k], acc[ai][bj][m][n], 0, 0, 0); __builtin_amdgcn_s_setprio(0); } while (0)
#define PG8_WAIT_V(n) asm volatile("s_waitcnt vmcnt(" #n ")" ::: "memory")
#define PG8_WAIT_L(n) asm volatile("s_waitcnt lgkmcnt(" #n ")" ::: "memory")
#define PG8_BAR __builtin_amdgcn_s_barrier()
#define PG8_SCHED __builtin_amdgcn_sched_barrier(0)
    Unit cur, nxt; int ui = 0;
    if (!S.next(0, cur)) return;
    f32x4 acc[2][2][4][2];
#pragma unroll
    for (int a = 0; a < 2; ++a)
#pragma unroll
        for (int b = 0; b < 2; ++b)
#pragma unroll
            for (int m = 0; m < 4; ++m)
#pragma unroll
                for (int n = 0; n < 2; ++n) acc[a][b][m][n] = (f32x4){0.f, 0.f, 0.f, 0.f};
    bf16x8 At[4][2], B0[2][2], B1[2][2];
    const char* cA = (const char*)(cur.z ? g.A1 : g.A0) + (size_t)cur.pm * tstepA; const char* cB = (const char*)(cur.z ? g.B1 : g.B0) + (size_t)cur.pn * tstepB;
    int nt = (cur.z ? g.K1 : g.K0) / BK;
    PG8_STAGE(PG8_SB(0, 0), cB, voffB); PG8_STAGE(PG8_SB(0, 1), cB + hstepB, voffB); PG8_STAGE(PG8_SA(0, 0), cA, voffA); PG8_STAGE(PG8_SA(0, 1), cA + hstepA, voffA);
    if (wr == 1) PG8_BAR;
    PG8_WAIT_V(2); PG8_BAR;
    PG8_STAGE(PG8_SB(1, 0), cB + kstep, voffB); PG8_STAGE(PG8_SA(1, 0), cA + kstep, voffA); PG8_STAGE(PG8_SB(1, 1), cB + hstepB + kstep, voffB);
    PG8_WAIT_V(6); PG8_BAR;
    for (;;) {
        const bool has_next = S.next(ui + 1, nxt);
        const char* nA = has_next ? (const char*)(nxt.z ? g.A1 : g.A0) + (size_t)nxt.pm * tstepA : cA; const char* nB = has_next ? (const char*)(nxt.z ? g.B1 : g.B0) + (size_t)nxt.pn * tstepB : cB;
#define PG8_W1(t) PG8_WAIT_V(8)
#define PG8_TRIP(t, W1) do { \
            const bool last = ((t) == nt - 2); \
            const char* a1 = cA + (size_t)((t) + 1) * kstep; \
            const char* a2 = last ? nA : cA + (size_t)((t) + 2) * kstep; const char* b2 = last ? nB : cB + (size_t)((t) + 2) * kstep; \
            const char* a3 = a2 + kstep; const char* b3 = b2 + kstep; \
              \
            PG8_LDB(B0, 0, 0); PG8_LDB(B1, 0, 1); PG8_SCHED; PG8_LDA(At, 0, 0); PG8_STAGE(PG8_SA(1, 1), a1 + hstepA, voffA); \
            PG8_W1(t); PG8_WAIT_L(0); PG8_BAR; PG8_MMA(0, 0, At, B0); PG8_MMA(0, 1, At, B1); PG8_BAR; PG8_SCHED; \
              \
            PG8_LDA(At, 0, 1); PG8_STAGE(PG8_SB(0, 0), b2, voffB); PG8_STAGE(PG8_SB(0, 1), b2 + hstepB, voffB); PG8_STAGE(PG8_SA(0, 0), a2, voffA); \
            PG8_W1(t); PG8_WAIT_L(0); PG8_BAR; PG8_MMA(1, 0, At, B0); PG8_MMA(1, 1, At, B1); PG8_BAR; PG8_SCHED; \
              \
            PG8_LDB(B0, 1, 0); PG8_LDB(B1, 1, 1); PG8_SCHED; PG8_LDA(At, 1, 0); PG8_STAGE(PG8_SA(0, 1), a2 + hstepA, voffA); \
            PG8_WAIT_V(8); PG8_WAIT_L(0); PG8_BAR; PG8_MMA(0, 0, At, B0); PG8_MMA(0, 1, At, B1); PG8_BAR; PG8_SCHED; \
              \
            PG8_LDA(At, 1, 1); PG8_STAGE(PG8_SB(1, 0), b3, voffB); PG8_STAGE(PG8_SB(1, 1), b3 + hstepB, voffB); PG8_STAGE(PG8_SA(1, 0), a3, voffA); \
            PG8_WAIT_V(8); PG8_WAIT_L(0); PG8_BAR; PG8_MMA(1, 0, At, B0); PG8_MMA(1, 1, At, B1); PG8_BAR; PG8_SCHED; } while (0)
        for (int t = 0; t < nt; t += 2) PG8_TRIP(t, 8);
        if constexpr (ALIGN_EPI) { if (wr == 0) PG8_BAR; }
        bool keep = false;
        if constexpr (Epi::CHAINZ) { if (cur.z == 0) { E.mid(acc, cur, wr, wc, fr, fq); keep = true; } else E(acc, cur, wr, wc, fr, fq); }
        else E(acc, cur, wr, wc, fr, fq);
        if (!has_next) break;
        if (!keep) {
#pragma unroll
        for (int a = 0; a < 2; ++a)
#pragma unroll
            for (int b = 0; b < 2; ++b)
#pragma unroll
                for (int m = 0; m < 4; ++m)
#pragma unroll
                    for (int n = 0; n < 2; ++n) acc[a][b][m][n] = (f32x4){0.f, 0.f, 0.f, 0.f};
        }
        cur = nxt; cA = nA; cB = nB; ++ui; nt = (cur.z ? g.K1 : g.K0) / BK;
        if constexpr (ALIGN_EPI) { if (wr == 1) PG8_BAR; }
    }
    PG8_WAIT_V(0);
    if constexpr (!ALIGN_EPI) { if (wr == 0) PG8_BAR; }
    PG8_BAR;
#undef PG8_TRIP
#undef PG8_W1
#undef PG8_SA
#undef PG8_SB
#undef PG8_STAGE
#undef PG8_LDA
#undef PG8_LDB
#undef PG8_MMA
#undef PG8_WAIT_V
#undef PG8_WAIT_L
#undef PG8_BAR
#undef PG8_SCHED
}

typedef f32x4 AccT[2][2][4][2];
__device__ __forceinline__ u32x4 pack8(const f32x4 v0, const f32x4 v1) { u32x4 w; w.x = cvt_pk_bf16(v0[0], v0[1]); w.y = cvt_pk_bf16(v0[2], v0[3]); w.z = cvt_pk_bf16(v1[0], v1[1]); w.w = cvt_pk_bf16(v1[2], v1[3]); return w; }
__device__ __forceinline__ void unpack8(const u32x4 w, f32x4& v0, f32x4& v1) {
    v0 = (f32x4){__uint_as_float(w.x << 16), __uint_as_float(w.x & 0xffff0000u), __uint_as_float(w.y << 16), __uint_as_float(w.y & 0xffff0000u)};
    v1 = (f32x4){__uint_as_float(w.z << 16), __uint_as_float(w.z & 0xffff0000u), __uint_as_float(w.w << 16), __uint_as_float(w.w & 0xffff0000u)}; }
__device__ __forceinline__ f32x4 sig4(const f32x4 v) { return (f32x4){sigmoidf_(v[0]), sigmoidf_(v[1]), sigmoidf_(v[2]), sigmoidf_(v[3])}; }
__device__ __forceinline__ float sumsq4(const f32x4 v) { return (v[0] * v[0] + v[1] * v[1]) + (v[2] * v[2] + v[3] * v[3]); }
__device__ __forceinline__ float rstd_from_ss(const float* ss, int row, int fq) {
    const f32x4 a = *(const f32x4*)(ss + (size_t)row * 16 + 4 * fq);
    float s = (a[0] + a[1]) + (a[2] + a[3]);
    s = sum_fq(s);
    return rsqrtf(s * (1.f / D) + EPS); }

struct EpiProj { static constexpr bool PERM = true, CHAINZ = false; bf16* O;
    __device__ __forceinline__ void operator()(const AccT& acc, const Unit& u, int wr, int wc, int fr, int fq) const {
        const int row0 = u.pm * BM + wr * 64 + fr, col0 = u.pn * BM + wc * 32 + 8 * fq;
        const bool iskr = (u.pn >= 14 && u.pn < 16);
        const float base = (u.pn < 4) ? QA_SCALE : (iskr ? KR_SCALE : 1.f);
        const float l2g0 = iskr ? ret_log2gamma(2 * (u.pn - 14)) : 0.f, l2g1 = iskr ? ret_log2gamma(2 * (u.pn - 14) + 1) : 0.f;
        float sc[2][4];
#pragma unroll
        for (int m = 0; m < 4; ++m) { const float e = -(float)(((16 * m + fr) & (RCH - 1)) + 1); sc[0][m] = base * __builtin_amdgcn_exp2f(e * l2g0); sc[1][m] = base * __builtin_amdgcn_exp2f(e * l2g1); }
#pragma unroll
        for (int ai = 0; ai < 2; ++ai)
#pragma unroll
            for (int m = 0; m < 4; ++m) { bf16* rowp = O + (size_t)(row0 + ai * HALF + m * 16) * PP + col0;
#pragma unroll
                for (int bj = 0; bj < 2; ++bj) *(u32x4*)(rowp + bj * HALF) = pack8(acc[ai][bj][m][0] * sc[bj][m], acc[ai][bj][m][1] * sc[bj][m]); }
    }
};
struct EpiGate { static constexpr bool PERM = true, CHAINZ = false; bf16* O;
    __device__ __forceinline__ void operator()(const AccT& acc, const Unit& u, int wr, int wc, int fr, int fq) const {
        const int row0 = u.pm * BM + wr * 64 + fr, col0 = u.pn * BM + wc * 32 + 8 * fq;
#pragma unroll
        for (int ai = 0; ai < 2; ++ai)
#pragma unroll
            for (int m = 0; m < 4; ++m) { bf16* rowp = O + (size_t)(row0 + ai * HALF + m * 16) * PP + col0;
#pragma unroll
                for (int bj = 0; bj < 2; ++bj) *(u32x4*)(rowp + bj * HALF) = pack8(acc[ai][bj][m][0], acc[ai][bj][m][1]); }
    }
};
struct EpiMix { static constexpr bool PERM = true, CHAINZ = true; const bf16* proj; bf16* mix;
    __device__ __forceinline__ void mid(AccT& acc, const Unit& u, int wr, int wc, int fr, int fq) const {
        const int row0 = u.pm * BM + wr * 64 + fr, col0 = u.pn * BM + wc * 32 + 8 * fq;
#pragma unroll
        for (int ai = 0; ai < 2; ++ai)
#pragma unroll
            for (int m = 0; m < 4; ++m) { const size_t r = (size_t)(row0 + ai * HALF + m * 16);
#pragma unroll
                for (int bj = 0; bj < 2; ++bj) { const int c = col0 + bj * HALF;
                    f32x4 a0, a1, b0, b1; unpack8(*(const u32x4*)(proj + r * PP + O_GA + c), a0, a1); unpack8(*(const u32x4*)(proj + r * PP + O_GB + c), b0, b1);
#pragma unroll
                    for (int e = 0; e < 4; ++e) {
                        acc[ai][bj][m][0][e] *= (1.f + __builtin_amdgcn_exp2f(-b0[e] * LOG2E)) * __builtin_amdgcn_rcpf(1.f + __builtin_amdgcn_exp2f(-a0[e] * LOG2E));
                        acc[ai][bj][m][1][e] *= (1.f + __builtin_amdgcn_exp2f(-b1[e] * LOG2E)) * __builtin_amdgcn_rcpf(1.f + __builtin_amdgcn_exp2f(-a1[e] * LOG2E)); } } }
    }
    __device__ __forceinline__ void operator()(const AccT& acc, const Unit& u, int wr, int wc, int fr, int fq) const {
        const int row0 = u.pm * BM + wr * 64 + fr, col0 = u.pn * BM + wc * 32 + 8 * fq;
#pragma unroll
        for (int ai = 0; ai < 2; ++ai)
#pragma unroll
            for (int m = 0; m < 4; ++m) { const size_t r = (size_t)(row0 + ai * HALF + m * 16);
#pragma unroll
                for (int bj = 0; bj < 2; ++bj) { const int c = col0 + bj * HALF;
                    f32x4 g0, g1; unpack8(*(const u32x4*)(proj + r * PP + O_GB + c), g0, g1);
                    *(u32x4*)(mix + r * D + c) = pack8(sig4(g0) * acc[ai][bj][m][0], sig4(g1) * acc[ai][bj][m][1]); } }
    }
};
template <bool IN_BF16> struct EpiRes { static constexpr bool PERM = true, CHAINZ = false; const float* xin; bf16* xb; float* ss;
    __device__ __forceinline__ void operator()(const AccT& acc, const Unit& u, int wr, int wc, int fr, int fq) const {
        const int row0 = u.pm * BM + wr * 64 + fr, col0 = u.pn * BM + wc * 32 + 8 * fq;
#pragma unroll
        for (int ai = 0; ai < 2; ++ai)
#pragma unroll
            for (int m = 0; m < 4; ++m) { const size_t r = (size_t)(row0 + ai * HALF + m * 16); float q = 0.f;
#pragma unroll
                for (int bj = 0; bj < 2; ++bj) { const size_t o = r * D + col0 + bj * HALF;
                    f32x4 x0, x1;
                    if (IN_BF16) unpack8(*(const u32x4*)(xb + o), x0, x1); else { x0 = *(const f32x4*)(xin + o); x1 = *(const f32x4*)(xin + o + 4); }
                    const f32x4 v0 = x0 + acc[ai][bj][m][0], v1 = x1 + acc[ai][bj][m][1];
                    *(u32x4*)(xb + o) = pack8(v0, v1);
                    q += sumsq4(v0) + sumsq4(v1); }
                q = sum_fq(q);
                if (fq == 0) ss[r * 16 + u.pn * 4 + wc] = q; }
    }
};
struct EpiHid { static constexpr bool PERM = true, CHAINZ = false; const float* ss; bf16* hid;
    __device__ __forceinline__ void operator()(const AccT& acc, const Unit& u, int wr, int wc, int fr, int fq) const {
        const int row0 = u.pm * BM + wr * 64 + fr, col0 = u.pn * BM + wc * 32 + 8 * fq;
#pragma unroll
        for (int ai = 0; ai < 2; ++ai)
#pragma unroll
            for (int m = 0; m < 4; ++m) { const int r = row0 + ai * HALF + m * 16; const float rstd = rstd_from_ss(ss, r, fq);
#pragma unroll
                for (int bj = 0; bj < 2; ++bj) { f32x4 v0 = acc[ai][bj][m][0] * rstd, v1 = acc[ai][bj][m][1] * rstd;
#pragma unroll
                    for (int e = 0; e < 4; ++e) { v0[e] = fmaxf(v0[e], 0.f); v1[e] = fmaxf(v1[e], 0.f); }
                    *(u32x4*)(hid + (size_t)r * FF + col0 + bj * HALF) = pack8(v0 * v0, v1 * v1); } }
    }
};
struct EpiPle { static constexpr bool PERM = true, CHAINZ = false; const float* ss2; bf16* part; const bf16* x2b; float* ss3;
    __device__ __forceinline__ void operator()(const AccT& acc, const Unit& u, int wr, int wc, int fr, int fq) const {
        const int row0 = u.pm * BM + wr * 64 + fr, col0 = u.pn * BM + wc * 32 + 8 * fq;
#pragma unroll
        for (int ai = 0; ai < 2; ++ai)
#pragma unroll
            for (int m = 0; m < 4; ++m) { const size_t r = (size_t)(row0 + ai * HALF + m * 16); float q = 0.f;
                const float rstd = u.z ? rstd_from_ss(ss2, (int)r, fq) : 1.f;
#pragma unroll
                for (int bj = 0; bj < 2; ++bj) { const size_t o = r * D + col0 + bj * HALF;
                    if (u.z == 0) { *(u32x4*)(part + o) = pack8(acc[ai][bj][m][0], acc[ai][bj][m][1]); }
                    else { f32x4 p0, p1, x0, x1; unpack8(*(const u32x4*)(part + o), p0, p1); unpack8(*(const u32x4*)(x2b + o), x0, x1);
                        const f32x4 v0 = x0 + sig4(acc[ai][bj][m][0] * rstd) * p0, v1 = x1 + sig4(acc[ai][bj][m][1] * rstd) * p1;
                        *(u32x4*)(part + o) = pack8(v0, v1); q += sumsq4(v0) + sumsq4(v1); } }
                if (u.z) { q = sum_fq(q); if (fq == 0) ss3[r * 16 + u.pn * 4 + wc] = q; } }
    }
};
}

namespace att {
typedef short bf16x8 __attribute__((ext_vector_type(8)));
typedef short s16x4 __attribute__((ext_vector_type(4)));
typedef float f32x16 __attribute__((ext_vector_type(16)));
constexpr int SHM_V = 16384, SHM_K = 16384;
constexpr int NBUF = 4, A_V = 0, A_K = NBUF * SHM_V, A_WS = A_K + NBUF * SHM_K, A_X = 0  , XPITCH = 132, X_BYTES = 17408, A_END = A_WS + 2048;
static_assert(4 * X_BYTES <= A_WS, "exchange region inside the tile buffers");
constexpr int A_G = 145408;
constexpr float THR = 8.f;
#define ATT_KSWZ(row, colB) ((row) * 256 + ((colB) ^ (((row) & 7) << 4)))
#define ATT_SBAR() __builtin_amdgcn_sched_barrier(0)
__device__ __forceinline__ int crow(int r, int hi) { return (r & 3) + 8 * (r >> 2) + 4 * hi; }
__device__ __forceinline__ unsigned cvtpk(float lo, float hi) { unsigned r; asm volatile("v_cvt_pk_bf16_f32 %0, %1, %2" : "=v"(r) : "v"(lo), "v"(hi)); return r; }
__device__ __forceinline__ int v_st(int k, int c) { const int kk = (k & ~0xC) | ((k & 4) << 1) | ((k & 8) >> 1); return ((kk >> 3) * 4 + (c >> 5)) * 512 + ((kk & 7) * 32 + (c & 31)) * 2; }
__device__ __forceinline__ int v_rd_base(int lane) { return ((lane & 3) << 3) | (((lane >> 2) & 3) << 6) | (((lane >> 4) & 1) << 5) | (((lane >> 5) & 1) << 8); }
constexpr int v_rd_off(int d0, int ks, int half) { return d0 * 512 + ks * 4096 + half * 2048; }
typedef short v4i16_t __attribute__((ext_vector_type(4)));
__device__ __forceinline__ s16x4 vtr(const LAS unsigned char* p) { return __builtin_bit_cast(s16x4, __builtin_amdgcn_ds_read_tr16_b64_v4i16((LAS v4i16_t*)p)); }
#define ATT_PK(L, H) (bf16x8){L[0], L[1], L[2], L[3], H[0], H[1], H[2], H[3]}
struct VFrag { s16x4 l0, h0, l1, h1, l2, h2, l3, h3; };
template <int D0> __device__ __forceinline__ void vload(VFrag& f, const LAS unsigned char* vp) {
  f.l0 = vtr(vp + v_rd_off(D0, 0, 0)); f.h0 = vtr(vp + v_rd_off(D0, 0, 1)); f.l1 = vtr(vp + v_rd_off(D0, 1, 0)); f.h1 = vtr(vp + v_rd_off(D0, 1, 1));
  f.l2 = vtr(vp + v_rd_off(D0, 2, 0)); f.h2 = vtr(vp + v_rd_off(D0, 2, 1)); f.l3 = vtr(vp + v_rd_off(D0, 3, 0)); f.h3 = vtr(vp + v_rd_off(D0, 3, 1));
}
__device__ __forceinline__ void pv_mma(f32x16& od, const VFrag& f, bf16x8 pa0, bf16x8 pa1, bf16x8 pa2, bf16x8 pa3) {
  od = __builtin_amdgcn_mfma_f32_32x32x16_bf16(pa0, ATT_PK(f.l0, f.h0), od, 0, 0, 0);
  od = __builtin_amdgcn_mfma_f32_32x32x16_bf16(pa1, ATT_PK(f.l1, f.h1), od, 0, 0, 0);
  od = __builtin_amdgcn_mfma_f32_32x32x16_bf16(pa2, ATT_PK(f.l2, f.h2), od, 0, 0, 0);
  od = __builtin_amdgcn_mfma_f32_32x32x16_bf16(pa3, ATT_PK(f.l3, f.h3), od, 0, 0, 0);
}
struct KFrag { bf16x8 a[2], b[2]; };
template <int H> __device__ __forceinline__ void kload(KFrag& k, const LAS unsigned char* Ks, int c, int r32, int hi) {
#pragma unroll
  for (int d = 0; d < 2; ++d) { const int cb = (c * 64 + (2 * H + d) * 16 + hi * 8) * 2;
    k.a[d] = *(const LAS bf16x8*)(Ks + ATT_KSWZ(r32, cb)); k.b[d] = *(const LAS bf16x8*)(Ks + ATT_KSWZ(32 + r32, cb)); }
}
template <bool DOPV> __device__ __forceinline__ void mma_stage(f32x16* o, f32x16& p0, f32x16& p1, const LAS unsigned char* vp, const LAS unsigned char* Ks, bf16x8 pa0, bf16x8 pa1, bf16x8 pa2, bf16x8 pa3,
                                                              const bf16x8* qr, bf16x8 kx0, bf16x8 kx1, bf16x8 qx, int c, int r32, int hi, const VFrag& f0, const KFrag& k0) {
  KFrag k1;
  if (DOPV) {
    VFrag fa = f0, fb;
    vload<1>(fb, vp); ATT_SBAR(); pv_mma(o[0], fa, pa0, pa1, pa2, pa3); ATT_SBAR();
    vload<2>(fa, vp); ATT_SBAR(); pv_mma(o[1], fb, pa0, pa1, pa2, pa3); ATT_SBAR();
    vload<3>(fb, vp); ATT_SBAR(); pv_mma(o[2], fa, pa0, pa1, pa2, pa3); ATT_SBAR();
    kload<1>(k1, Ks, c, r32, hi); ATT_SBAR(); pv_mma(o[3], fb, pa0, pa1, pa2, pa3); ATT_SBAR();
  } else kload<1>(k1, Ks, c, r32, hi);
  p0 = __builtin_amdgcn_mfma_f32_32x32x16_bf16(kx0, qx, f32x16{}, 0, 0, 0); p1 = __builtin_amdgcn_mfma_f32_32x32x16_bf16(kx1, qx, f32x16{}, 0, 0, 0);
#pragma unroll
  for (int d = 0; d < 2; ++d) { p0 = __builtin_amdgcn_mfma_f32_32x32x16_bf16(k0.a[d], qr[d], p0, 0, 0, 0); p1 = __builtin_amdgcn_mfma_f32_32x32x16_bf16(k0.b[d], qr[d], p1, 0, 0, 0); }
#pragma unroll
  for (int d = 0; d < 2; ++d) { p0 = __builtin_amdgcn_mfma_f32_32x32x16_bf16(k1.a[d], qr[2 + d], p0, 0, 0, 0); p1 = __builtin_amdgcn_mfma_f32_32x32x16_bf16(k1.b[d], qr[2 + d], p1, 0, 0, 0); }
}
__device__ __forceinline__ void pv_d0(f32x16* o, const LAS unsigned char* vp, bf16x8 pa0, bf16x8 pa1, bf16x8 pa2, bf16x8 pa3, const VFrag& f0) {
  VFrag fa = f0, fb;
  vload<1>(fb, vp); ATT_SBAR(); pv_mma(o[0], fa, pa0, pa1, pa2, pa3); ATT_SBAR();
  vload<2>(fa, vp); ATT_SBAR(); pv_mma(o[1], fb, pa0, pa1, pa2, pa3); ATT_SBAR();
  vload<3>(fb, vp); ATT_SBAR(); pv_mma(o[2], fa, pa0, pa1, pa2, pa3); ATT_SBAR();
  pv_mma(o[3], fb, pa0, pa1, pa2, pa3);
}
__device__ __forceinline__ float vmax3(float a, float b, float c) { float r; asm("v_max3_f32 %0, %1, %2, %3" : "=v"(r) : "v"(a), "v"(b), "v"(c)); return r; }
__device__ __forceinline__ float vmax2(float a, float b) { float r; asm("v_max_f32 %0, %1, %2" : "=v"(r) : "v"(a), "v"(b)); return r; }
template <bool MASK> __device__ __forceinline__ bool softmax_stage(f32x16& p0, f32x16& p1, float& m_ref, float& l_reg, f32x16* o, bf16x8& pa0, bf16x8& pa1, bf16x8& pa2, bf16x8& pa3,
                                                                  int qrel, int hi, int r32, LAS float* al_l) {
  if (MASK) {
    int qa = qrel - 4 * hi; asm volatile("" : "+v"(qa));
#pragma unroll
    for (int r = 0; r < 16; ++r) { const int cr = (r & 3) + 8 * (r >> 2); p0[r] = (cr > qa) ? -INFINITY : p0[r]; p1[r] = (cr + 32 > qa) ? -INFINITY : p1[r]; }
  }
  float pmax, pmb;
  pmax = vmax3(p0[0], p0[1], p0[2]); pmb = vmax3(p1[0], p1[1], p1[2]);
#pragma unroll
  for (int k = 0; k < 6; ++k) { pmax = vmax3(pmax, p0[3 + 2 * k], p0[4 + 2 * k]); pmb = vmax3(pmb, p1[3 + 2 * k], p1[4 + 2 * k]); }
  pmax = vmax3(pmax, p0[15], p1[15]);
  { const float m2 = vmax2(pmax, pmb); auto rr = __builtin_amdgcn_permlane32_swap(__float_as_uint(m2), __float_as_uint(m2), false, false); pmax = vmax2(__uint_as_float(rr[0]), __uint_as_float(rr[1])); }
  if (__all(pmax < -140.f)) return false;
  float alpha = 1.f;
  if (__builtin_expect(!__all(pmax <= THR), 0)) {
    const float dl = fmaxf(pmax, 0.f); alpha = __builtin_amdgcn_exp2f(-dl); m_ref += dl;
#pragma unroll
    for (int r = 0; r < 16; ++r) { p0[r] -= dl; p1[r] -= dl; }
    if (hi == 0) al_l[r32] = alpha; asm volatile("s_waitcnt lgkmcnt(0)" ::: "memory");
#pragma unroll
    for (int d = 0; d < 4; ++d)
#pragma unroll
      for (int r = 0; r < 16; ++r) o[d][r] *= al_l[crow(r, hi)];
  }
#pragma unroll
  for (int r = 0; r < 16; ++r) { p0[r] = __builtin_amdgcn_exp2f(p0[r]); p1[r] = __builtin_amdgcn_exp2f(p1[r]); }
  float ps = p0[0] + p1[0];
#pragma unroll
  for (int r = 1; r < 16; ++r) { ps += p0[r]; ps += p1[r]; }
  { auto rr = __builtin_amdgcn_permlane32_swap(__float_as_uint(ps), __float_as_uint(ps), false, false); ps = __uint_as_float(rr[0]) + __uint_as_float(rr[1]); }
  l_reg = l_reg * alpha + ps;
#define ATT_PK4(P, BASE, OUT) do { unsigned a0 = cvtpk(P[BASE + 0], P[BASE + 1]), a1 = cvtpk(P[BASE + 2], P[BASE + 3]);   \
    unsigned b0 = cvtpk(P[BASE + 4], P[BASE + 5]), b1 = cvtpk(P[BASE + 6], P[BASE + 7]);                              \
    auto r0 = __builtin_amdgcn_permlane32_swap(a0, b0, false, false); auto r1 = __builtin_amdgcn_permlane32_swap(a1, b1, false, false); \
    u32x4 w = {r0[0], r1[0], r0[1], r1[1]}; OUT = __builtin_bit_cast(bf16x8, w); } while (0)
  ATT_PK4(p0, 0, pa0); ATT_PK4(p0, 8, pa1); ATT_PK4(p1, 0, pa2); ATT_PK4(p1, 8, pa3);
#undef ATT_PK4
  return true;
}

__device__ __forceinline__ void attn_unit(LAS unsigned char* lds, const bf16* __restrict__ proj, bf16* __restrict__ ya, int b, int h, int qb, float lam, const float* __restrict__ gdiff) {
  int tid_ = threadIdx.x; asm volatile("" : "+v"(tid_));
  const int tid = tid_, wid = __builtin_amdgcn_readfirstlane(tid >> 6), lane = tid & 63, r32 = lane & 31, hi = lane >> 5, c = wid >> 2, rg = wid & 3;
  const int q0 = qb * 128, NT = 2 * (qb + 1), qloc = rg * 32 + r32;
  const size_t rowbase = (size_t)b * S;
  const bf16* Kh = proj + rowbase * PP + O_KA + h * 128; const bf16* Vh = proj + rowbase * PP + O_VA + h * 128;
  const bf16* Qw = proj + (rowbase + q0 + qloc) * PP + O_QA + h * 128 + c * 64 + hi * 8;
  LAS unsigned char* V_lds = lds + A_V; LAS unsigned char* K_lds = lds + A_K;
  LAS float* wsf = (LAS float*)(lds + A_WS) + wid * 64; LAS float* li_l = wsf; LAS float* al_l = wsf + 32;
  float l_reg = 0; f32x16 o[4] = {}; bf16x8 qr[4];
#pragma unroll
  for (int d0 = 0; d0 < 4; ++d0) qr[d0] = *(const bf16x8*)(Qw + d0 * 16);
  const LAS unsigned char* vp0 = V_lds + v_rd_base(lane);
  const float slope2 = __builtin_amdgcn_exp2f(-(float)(h + 1)) * LOG2E;
  bf16x8 kx0 = bf16x8{}, kx1 = bf16x8{}; unsigned qxw0 = 0u;
  { const unsigned shi = __float_as_uint(slope2) & 0xffff0000u; const float slo = slope2 - __uint_as_float(shi);
    const unsigned k0 = __float_as_uint((float)r32) >> 16, k1 = __float_as_uint((float)(32 + r32)) >> 16;
    if (hi == 0) { u32x4 w = {k0 | (k0 << 16), 0x3f803f80u, 0x00003f80u, 0u}; kx0 = __builtin_bit_cast(bf16x8, w); w.x = k1 | (k1 << 16); kx1 = __builtin_bit_cast(bf16x8, w);
                   qxw0 = (shi >> 16) | ((unsigned)f2bf(slo) << 16); } }
  const unsigned himask = hi ? 0u : 0xffffffffu;
  unsigned kso[2], vso[2];
#pragma unroll
  for (int j = 0; j < 2; ++j) { const int pc = wid * 2 + j;
    { const int row = 4 * pc + (lane >> 4), ch = (lane & 15) ^ (row & 7); kso[j] = (unsigned)(row * PP + ch * 8); }
    { const int st = 2 * pc + (lane >> 5), i5 = lane & 31, kk = (st >> 2) * 8 + (i5 >> 2), k = (kk & ~0xC) | ((kk & 4) << 1) | ((kk & 8) >> 1), cc = (st & 3) * 32 + (i5 & 3) * 8;
      vso[j] = (unsigned)(k * PP + cc); } }
#define ATT_DMA16(gp, la) asm volatile("s_mov_b32 m0, %1\n\ts_nop 0\n\tglobal_load_lds_dwordx4 %0, off" :: "v"(gp), "s"(la) : "memory", "m0")
#define ATT_DMAK(t, bf) do { _Pragma("unroll") for (int j_ = 0; j_ < 2; ++j_) ATT_DMA16(Kh + (size_t)(64 * (t)) * PP + kso[j_], (unsigned)(size_t)(K_lds + (bf) * SHM_K + (wid * 2 + j_) * 1024)); } while (0)
#define ATT_DMAV(t, bf) do { _Pragma("unroll") for (int j_ = 0; j_ < 2; ++j_) ATT_DMA16(Vh + (size_t)(64 * (t)) * PP + vso[j_], (unsigned)(size_t)(V_lds + (bf) * SHM_V + (wid * 2 + j_) * 1024)); } while (0)
#define ATT_BAR() do { asm volatile("" ::: "memory"); __builtin_amdgcn_s_waitcnt(0xC07F); __builtin_amdgcn_s_barrier(); asm volatile("" ::: "memory"); } while (0)
#define ATT_BARV() do { asm volatile("" ::: "memory"); __builtin_amdgcn_s_waitcnt(0x0070); __builtin_amdgcn_s_barrier(); asm volatile("" ::: "memory"); } while (0)
  f32x16 p0, p1; bf16x8 pa0 = bf16x8{}, pa1 = bf16x8{}, pa2 = bf16x8{}, pa3 = bf16x8{}; bool dopv = false;
#define ATT_ITER(MASK, i_) do { const int i = (i_), t = NT - 1 - i; \
    bf16x8 qx; { const float v_ = slope2 * (float)(64 * t - (q0 + 127)) - m_ref; const unsigned v1_ = __float_as_uint(v_) & 0xffff0000u; const float r1_ = v_ - __uint_as_float(v1_); \
      const unsigned v2_ = __float_as_uint(r1_) & 0xffff0000u; const float r2_ = r1_ - __uint_as_float(v2_); \
      const u32x4 w_ = {qxw0, ((v1_ >> 16) | v2_) & himask, (unsigned)f2bf(r2_) & himask, 0u}; qx = __builtin_bit_cast(bf16x8, w_); } \
    if (dopv) mma_stage<true>(o, p0, p1, vp0 + ((i - 1) & 3) * SHM_V, K_lds + (i & 3) * SHM_K, pa0, pa1, pa2, pa3, qr, kx0, kx1, qx, c, r32, hi, vf0, kf0); \
    else mma_stage<false>(o, p0, p1, vp0 + ((i - 1) & 3) * SHM_V, K_lds + (i & 3) * SHM_K, pa0, pa1, pa2, pa3, qr, kx0, kx1, qx, c, r32, hi, vf0, kf0); \
    ATT_BAR(); \
      \
    asm volatile("s_nop 15" : "+v"(p0), "+v"(p1)); \
    dopv = softmax_stage<MASK>(p0, p1, m_ref, l_reg, o, pa0, pa1, pa2, pa3, q0 + qloc - 64 * t, hi, r32, al_l); \
      \
    vload<0>(vf0, vp0 + (i & 3) * SHM_V); kload<0>(kf0, K_lds + ((i + 1) & 3) * SHM_K, c, r32, hi); \
    asm volatile("" ::: "memory"); __builtin_amdgcn_s_waitcnt(0x0F70);     \
      \
    if (i + 2 < NT) { ATT_DMAV(t - 2, (i + 2) & 3); if (i + 3 < NT) ATT_DMAK(t - 3, (i + 3) & 3); } \
    ATT_BAR(); } while (0)
  VFrag vf0; KFrag kf0;
  float m_ref = slope2 * (float)(64 * (NT - 1) - (q0 + 127));
  ATT_DMAK(NT - 1, 0); ATT_DMAV(NT - 1, 0); ATT_DMAK(NT - 2, 1);
  ATT_DMAV(NT - 2, 1);
  asm volatile("" ::: "memory");
  if (NT > 2) { ATT_DMAK(NT - 3, 2); __builtin_amdgcn_s_waitcnt(0x0F74); } else __builtin_amdgcn_s_waitcnt(0x0F72);
  ATT_BAR();
  kload<0>(kf0, K_lds, c, r32, hi); vload<0>(vf0, vp0);
  if (c == 1) { ATT_BAR(); __builtin_amdgcn_s_setprio(1); }
  ATT_ITER(true, 0); ATT_ITER(true, 1);
  for (int it = 2; it < NT; ++it) ATT_ITER(false, it);
  if (dopv) pv_d0(o, vp0 + ((NT - 1) & 3) * SHM_V, pa0, pa1, pa2, pa3, vf0);
  __builtin_amdgcn_s_setprio(0);
  if (c == 0) ATT_BAR();
#undef ATT_ITER
  ATT_BAR();
  if (hi == 0) li_l[r32] = l_reg; asm volatile("s_waitcnt lgkmcnt(0)" ::: "memory");
  float rli[16];
#pragma unroll
  for (int r = 0; r < 16; ++r) rli[r] = __builtin_amdgcn_rcpf(li_l[crow(r, hi)]);
  LAS float* X = (LAS float*)(lds + A_X + rg * X_BYTES);
  if (c == 1) {
#pragma unroll
    for (int d0 = 0; d0 < 4; ++d0)
#pragma unroll
      for (int r = 0; r < 16; ++r) X[(d0 * 16 + r) * 64 + lane] = o[d0][r] * rli[r];
  }
  ATT_BAR();
  if (c == 0) {
#pragma unroll
    for (int d0 = 0; d0 < 4; ++d0)
#pragma unroll
      for (int r = 0; r < 16; ++r) o[d0][r] = o[d0][r] * rli[r] - lam * X[(d0 * 16 + r) * 64 + lane];
    asm volatile("s_waitcnt lgkmcnt(0)" ::: "memory"); __builtin_amdgcn_wave_barrier();
#pragma unroll
    for (int d0 = 0; d0 < 4; ++d0)
#pragma unroll
      for (int r = 0; r < 16; ++r) X[crow(r, hi) * XPITCH + d0 * 32 + r32] = o[d0][r];
    asm volatile("s_waitcnt lgkmcnt(0)" ::: "memory"); __builtin_amdgcn_wave_barrier();
    const int row = lane >> 1, half = lane & 1;
    const LAS f32x4* yr = (const LAS f32x4*)(X + row * XPITCH + half * 64);
    f32x4 yv[16]; float ssq = 0.f;
#pragma unroll
    for (int i = 0; i < 16; ++i) { yv[i] = yr[i]; ssq += (yv[i][0] * yv[i][0] + yv[i][1] * yv[i][1]) + (yv[i][2] * yv[i][2] + yv[i][3] * yv[i][3]); }
    ssq += __shfl_xor(ssq, 1);
    const float sc_ = rsqrtf(ssq * (1.f / 128.f) + EPS); const LAS f32x4* Gl = (const LAS f32x4*)(lds + A_G) + half * 16;
    bf16* orow = ya + (rowbase + q0 + rg * 32 + row) * PP + h * 128 + half * 64;
#pragma unroll
    for (int i = 0; i < 8; ++i) { const f32x4 g0 = Gl[2 * i], g1 = Gl[2 * i + 1];
      u32x4 w; w.x = cvtpk(yv[2 * i][0] * sc_ * g0[0], yv[2 * i][1] * sc_ * g0[1]); w.y = cvtpk(yv[2 * i][2] * sc_ * g0[2], yv[2 * i][3] * sc_ * g0[3]);
      w.z = cvtpk(yv[2 * i + 1][0] * sc_ * g1[0], yv[2 * i + 1][1] * sc_ * g1[1]); w.w = cvtpk(yv[2 * i + 1][2] * sc_ * g1[2], yv[2 * i + 1][3] * sc_ * g1[3]);
      *(u32x4*)(orow + 8 * i) = w; }
  }
  ATT_BAR();
#undef ATT_DMAK
#undef ATT_DMAV
#undef ATT_BAR
#undef ATT_BARV
}
}


namespace ret {
using att::bf16x8; using att::s16x4; using att::f32x16; using att::crow; using att::cvtpk;
constexpr int QP = 272, KP = 320, VP = 576, OP = 260;
constexpr int SZ_Q = 32 * QP, SZ_K = 32 * KP, SZ_V = 32 * VP, SZ_BUF = SZ_Q + SZ_K + SZ_V, R_OUT = 2 * SZ_BUF, R_GAIN = R_OUT + 32 * OP * 4, R_END = R_GAIN + 1024;
static_assert(SZ_BUF % 16 == 0 && R_OUT % 16 == 0, "LDS alignment");
__device__ __forceinline__ s16x4 trr(int addr) { return __builtin_bit_cast(s16x4, __builtin_amdgcn_ds_read_tr16_b64_v4i16((LAS att::v4i16_t*)(unsigned)addr)); }
#define RET_PK(L, H) (bf16x8){L[0], L[1], L[2], L[3], H[0], H[1], H[2], H[3]}
#define RET_PK4(P, BASE, OUT) do { unsigned a0 = cvtpk(P[BASE + 0], P[BASE + 1]), a1 = cvtpk(P[BASE + 2], P[BASE + 3]);   \
    unsigned b0 = cvtpk(P[BASE + 4], P[BASE + 5]), b1 = cvtpk(P[BASE + 6], P[BASE + 7]);                              \
    auto r0 = __builtin_amdgcn_permlane32_swap(a0, b0, false, false); auto r1 = __builtin_amdgcn_permlane32_swap(a1, b1, false, false); \
    u32x4 w_ = {r0[0], r1[0], r0[1], r1[1]}; OUT = __builtin_bit_cast(bf16x8, w_); } while (0)
__device__ __forceinline__ void ret_chain(LAS unsigned char* lds, const bf16* __restrict__ proj, bf16* __restrict__ yr, int b, int h, const float* __restrict__ gret) {
  int tid_ = threadIdx.x; asm volatile("" : "+v"(tid_));
  const int tid = tid_, w = __builtin_amdgcn_readfirstlane(tid >> 6), lane = tid & 63, r32 = lane & 31, hi = lane >> 5, g16 = (lane >> 4) & 1, i16 = lane & 15, q4 = i16 >> 2, p4 = i16 & 3;
  const size_t rowbase = (size_t)b * S;
  const float l2g = ret_log2gamma(h), gC = __builtin_amdgcn_exp2f(l2g * (float)RCH);
  const int srow = tid >> 4, sch = tid & 15;
  const bf16* qsrc = proj + (rowbase + srow) * PP + O_QR + h * 128 + sch * 8;
  const bf16* ksrc = proj + (rowbase + srow) * PP + O_KR + h * 128 + sch * 8;
  const bf16* vsrc = proj + (rowbase + srow) * PP + O_VR + h * 256 + sch * 8;
  const int qdst = srow * QP + sch * 16, kdst = SZ_Q + srow * KP + sch * 16, vdst = SZ_Q + SZ_K + srow * VP + sch * 16;
  const int ldsb = (int)(unsigned)(uintptr_t)lds;
  const int qrd = r32 * QP + hi * 16, krd = SZ_Q + r32 * KP + hi * 16;
  const int ktr = ldsb + SZ_Q + (8 * hi + q4) * KP + (16 * g16 + 4 * p4) * 2;
  const int vtr = ldsb + SZ_Q + SZ_K + (8 * hi + q4) * VP + (32 * w + 16 * g16 + 4 * p4) * 2;
  const int erow = tid >> 4, ec0 = (tid & 15) * 16;
  struct { bf16x8 q, k, v0, v1; } st;
#define RET_LOADS(i) do { const size_t ro_ = (size_t)(i) * RCH * PP; st.q = *(const bf16x8*)(qsrc + ro_); st.k = *(const bf16x8*)(ksrc + ro_); st.v0 = *(const bf16x8*)(vsrc + ro_); st.v1 = *(const bf16x8*)(vsrc + ro_ + 128); } while (0)
#define RET_WRITE(bf) do { LAS unsigned char* d_ = lds + (bf) * SZ_BUF; *(LAS bf16x8*)(d_ + qdst) = st.q; *(LAS bf16x8*)(d_ + kdst) = st.k; *(LAS bf16x8*)(d_ + vdst) = st.v0; *(LAS bf16x8*)(d_ + vdst + 256) = st.v1; } while (0)
  if (tid < 256) ((LAS float*)(lds + R_GAIN))[tid] = gret[h * 256 + tid];
  f32x16 R[4];
#pragma unroll
  for (int kb = 0; kb < 4; ++kb) R[kb] = f32x16{};
  float qd[16];
#pragma unroll
  for (int r = 0; r < 16; ++r) qd[r] = __builtin_amdgcn_exp2f(l2g * (float)(crow(r, hi) + 1));
  RET_LOADS(0); asm volatile("s_waitcnt vmcnt(0)" ::: "memory"); RET_WRITE(0); RET_LOADS(1);
  constexpr int NCH = S / RCH;
  for (int i = 0; i < NCH; ++i) {
    const int bf = i & 1;
    asm volatile("s_waitcnt lgkmcnt(0)\n\ts_barrier" ::: "memory");
    if (i + 1 < NCH) { RET_WRITE(bf ^ 1); if (i + 2 < NCH) RET_LOADS(i + 2); }
    const size_t erow_g = rowbase + (size_t)i * RCH + erow;
    const u32x4 gr0 = *(const u32x4*)(proj + erow_g * PP + O_GR + h * 256 + ec0), gr1 = *(const u32x4*)(proj + erow_g * PP + O_GR + h * 256 + ec0 + 8);
    const LAS unsigned char* B_ = lds + bf * SZ_BUF; const int boff = bf * SZ_BUF;
    bf16x8 qf[8]; f32x16 x = f32x16{};
#pragma unroll
    for (int s_ = 0; s_ < 8; ++s_) qf[s_] = *(const LAS bf16x8*)(B_ + qrd + 32 * s_);
    bf16x8 vf0, vf1;
    { const s16x4 l0 = trr(vtr + boff), h0 = trr(vtr + boff + 4 * VP), l1 = trr(vtr + boff + 16 * VP), h1 = trr(vtr + boff + 20 * VP);
      vf0 = RET_PK(l0, h0); vf1 = RET_PK(l1, h1); }
    { bf16x8 kf[8];
#pragma unroll
      for (int s_ = 0; s_ < 8; ++s_) kf[s_] = *(const LAS bf16x8*)(B_ + krd + 32 * s_);
      __builtin_amdgcn_sched_barrier(0);
#pragma unroll
      for (int s_ = 0; s_ < 8; ++s_) x = __builtin_amdgcn_mfma_f32_32x32x16_bf16(kf[s_], qf[s_], x, 0, 0, 0); }
#pragma unroll
    for (int r = 0; r < 16; ++r) x[r] = (crow(r, hi) <= r32) ? x[r] : 0.f;
    bf16x8 xa0, xa1; RET_PK4(x, 0, xa0); RET_PK4(x, 8, xa1);
    f32x16 o = __builtin_amdgcn_mfma_f32_32x32x16_bf16(xa0, vf0, f32x16{}, 0, 0, 0); o = __builtin_amdgcn_mfma_f32_32x32x16_bf16(xa1, vf1, o, 0, 0, 0);
#pragma unroll
    for (int kb = 0; kb < 4; ++kb) { bf16x8 rb0, rb1; RET_PK4(R[kb], 0, rb0); RET_PK4(R[kb], 8, rb1);
      o = __builtin_amdgcn_mfma_f32_32x32x16_bf16(qf[2 * kb], rb0, o, 0, 0, 0); o = __builtin_amdgcn_mfma_f32_32x32x16_bf16(qf[2 * kb + 1], rb1, o, 0, 0, 0); }
#pragma unroll
    for (int kb = 0; kb < 4; ++kb) {
      const s16x4 l0 = trr(ktr + boff + 64 * kb), h0 = trr(ktr + boff + 64 * kb + 4 * KP), l1 = trr(ktr + boff + 64 * kb + 16 * KP), h1 = trr(ktr + boff + 64 * kb + 20 * KP);
      R[kb] = __builtin_amdgcn_mfma_f32_32x32x16_bf16(RET_PK(l0, h0), vf0, R[kb], 0, 0, 0); R[kb] = __builtin_amdgcn_mfma_f32_32x32x16_bf16(RET_PK(l1, h1), vf1, R[kb], 0, 0, 0);
#pragma unroll
      for (int r = 0; r < 16; ++r) R[kb][r] *= gC; }
    LAS float* OUT = (LAS float*)(lds + R_OUT);
#pragma unroll
    for (int r = 0; r < 16; ++r) OUT[crow(r, hi) * OP + 32 * w + r32] = o[r] * qd[r];
    asm volatile("s_waitcnt lgkmcnt(0)\n\ts_barrier" ::: "memory");
    { const LAS f32x4* orow = (const LAS f32x4*)(OUT + erow * OP + ec0); f32x4 v[4]; float ssq = 0.f;
#pragma unroll
      for (int k = 0; k < 4; ++k) { v[k] = orow[k]; ssq += (v[k][0] * v[k][0] + v[k][1] * v[k][1]) + (v[k][2] * v[k][2] + v[k][3] * v[k][3]); }
      ssq += __shfl_xor(ssq, 1); ssq += __shfl_xor(ssq, 2); ssq += __shfl_xor(ssq, 4); ssq += __shfl_xor(ssq, 8);
      const float rstd = rsqrtf(ssq * (1.f / 256.f) + EPS);
      f32x4 a0, a1, a2, a3; pg8::unpack8(gr0, a0, a1); pg8::unpack8(gr1, a2, a3);
      f32x4 gate[4] = {a0, a1, a2, a3};
#pragma unroll
      for (int k = 0; k < 4; ++k) { const f32x4 gg = *(const LAS f32x4*)(lds + R_GAIN + (ec0 + 4 * k) * 4);
#pragma unroll
        for (int e = 0; e < 4; ++e) v[k][e] = v[k][e] * rstd * gg[e] * (gate[k][e] * sigmoidf_(gate[k][e])); }
      bf16* dst = yr + erow_g * PP + h * 256 + ec0;
      *(u32x4*)dst = pg8::pack8(v[0], v[1]); *(u32x4*)(dst + 8) = pg8::pack8(v[2], v[3]); }
  }
  asm volatile("s_waitcnt lgkmcnt(0)\n\ts_barrier" ::: "memory");
#undef RET_LOADS
#undef RET_WRITE
}
#undef RET_PK
#undef RET_PK4
}

struct LamPtrs { const float* q1; const float* k1; const float* q2; const float* k2; };
__device__ __forceinline__ float compute_lam(const LamPtrs& L, int lane) {
    const float a = wave_sum(L.q1[lane] * L.k1[lane]), b = wave_sum(L.q2[lane] * L.k2[lane]);
    return __expf(a) - __expf(b) + LAM_INIT;
}

#define XB_TMO      128
#define XB_XCNT(j)  (256  + 64 * (j))
#define XB_XSUB(j)  (1280 + 64 * (j))
#define XB_XGEN(j)  (2304 + 64 * (j))
#define XB_TOP      3328
#define XB_TOPGEN   3392
#define XCD_BAR_WORDS 3456
#define XB_SPIN_CAP (1u << 23)
__device__ __forceinline__ unsigned xb_ld(unsigned* p)              { return __hip_atomic_load(p, __ATOMIC_RELAXED, __HIP_MEMORY_SCOPE_AGENT); }
__device__ __forceinline__ unsigned xb_add(unsigned* p, unsigned v) { return __hip_atomic_fetch_add(p, v, __ATOMIC_RELAXED, __HIP_MEMORY_SCOPE_AGENT); }
__device__ __forceinline__ unsigned xb_xcc_id() { return (unsigned)__builtin_amdgcn_s_getreg((3 << 11) | 20) & 0xFu; }
#define XB_SPIN(cond, bar) do { unsigned _sp = 0; while (cond) { __builtin_amdgcn_s_sleep(1); \
    if ((++_sp & 255u) == 0u) { if (xb_ld(&(bar)[XB_TMO])) break; if (_sp > XB_SPIN_CAP) { atomicAdd(&(bar)[XB_TMO], 1u); break; } } } } while (0)
struct XcdBarrier { unsigned* bar; unsigned x; volatile LAS unsigned* st; };
__device__ __forceinline__ XcdBarrier xcd_barrier_post(unsigned* bar, volatile LAS unsigned* st) {
    XcdBarrier b; b.bar = bar; b.x = xb_xcc_id(); b.st = st;
    if (threadIdx.x == 0) (void)xb_add(&bar[XB_XCNT(b.x)], 1u);
    return b;
}
__device__ __forceinline__ void xcd_barrier_complete(unsigned* bar, unsigned x, unsigned& nloc, unsigned& nx) {
    const unsigned G = gridDim.x * gridDim.y * gridDim.z;
    unsigned sum, cnt, mine, sp = 0u;
    for (;;) {
        sum = 0u; cnt = 0u; mine = 0u;
#pragma unroll
        for (unsigned j = 0; j < 16; ++j) { const unsigned c = xb_ld(&bar[XB_XCNT(j)]); sum += c; cnt += (c > 0u) ? 1u : 0u; mine = (j == x) ? c : mine; }
        if (sum == G) break;
        __builtin_amdgcn_s_sleep(1);
        if ((++sp & 255u) == 0u) { if (xb_ld(&bar[XB_TMO])) break; if (sp > XB_SPIN_CAP) { atomicAdd(&bar[XB_TMO], 1u); break; } }
    }
    nloc = mine > 0u ? mine : 1u; nx = cnt > 0u ? cnt : 1u;
}
__device__ __forceinline__ void xcd_barrier(const XcdBarrier& b) {
    asm volatile("s_waitcnt vmcnt(0)" ::: "memory");
    __syncthreads();
    if (threadIdx.x == 0) {
        unsigned* bar = b.bar;
        __builtin_amdgcn_s_waitcnt(0);
        unsigned nloc = b.st[0], nx = b.st[1];
        if (nloc == 0u) { xcd_barrier_complete(bar, b.x, nloc, nx); b.st[0] = nloc; b.st[1] = nx; }
        const unsigned old = xb_add(&bar[XB_XSUB(b.x)], 1u);
        const unsigned gen = old / nloc;
        if (old + 1u == (gen + 1u) * nloc) {
            __builtin_amdgcn_fence(__ATOMIC_RELEASE, "agent");
            asm volatile("s_waitcnt vmcnt(0)" ::: "memory");
            const unsigned og = xb_add(&bar[XB_TOP], 1u);
            const unsigned tg = og / nx;
            if (og + 1u == (tg + 1u) * nx) xb_add(&bar[XB_TOPGEN], 1u);
            else XB_SPIN(xb_ld(&bar[XB_TOPGEN]) == tg, bar);
            __builtin_amdgcn_fence(__ATOMIC_ACQUIRE, "agent");
            xb_add(&bar[XB_XGEN(b.x)], 1u);
            asm volatile("s_waitcnt vmcnt(0)" ::: "memory");
        } else {
            XB_SPIN(xb_ld(&bar[XB_XGEN(b.x)]) == gen, bar);
            __builtin_amdgcn_fence(__ATOMIC_ACQUIRE, "agent");
            asm volatile("s_waitcnt vmcnt(0)" ::: "memory");
        }
    }
    __syncthreads();
}

constexpr int NWAVES = 8;
constexpr int LDS_BYTES = 147456, LDSCTL_OFF = LDS_BYTES - 1024, MISC_OFF = LDSCTL_OFF + 320;
static_assert(att::A_G + 512 <= LDSCTL_OFF && att::A_END <= att::A_G && ret::R_END <= att::A_G && 7 * 16384 + 8448 <= att::A_G && pg8::STAGE_BYTES <= LDSCTL_OFF && ret::R_END <= LDSCTL_OFF, "LDS map");
constexpr int CW_QUEUE = 16384;
constexpr int N_PHASES = 10;

struct P0Item { const float* W; const float* gain; bf16* WT; int N, ldt, k0, n0; };
__device__ __forceinline__ void p0_load(const P0Item& I, int lane, f32x4 (&v)[10]) {
    const int c = lane & 7;
    const float* gp = I.gain ? I.gain + I.k0 + 8 * c : I.W;
    v[8] = *(const f32x4*)gp; v[9] = *(const f32x4*)(gp + 4);
#pragma unroll
    for (int i = 0; i < 8; ++i) v[i] = *(const f32x4*)(I.W + (size_t)(I.k0 + 8 * i + (lane >> 3)) * I.N + I.n0 + 4 * c);
}
__device__ __forceinline__ void p0_store(const P0Item& I, int lane, const f32x4 (&v)[10], LAS float* scr) {
    const int c = lane & 7;
    const f32x4 one = {1.f, 1.f, 1.f, 1.f}; const f32x4 g0 = I.gain ? v[8] : one, g1 = I.gain ? v[9] : one;
#pragma unroll
    for (int i = 0; i < 8; ++i) { LAS float* d = scr + (8 * i + (lane >> 3)) * 33 + 4 * c; d[0] = v[i].x; d[1] = v[i].y; d[2] = v[i].z; d[3] = v[i].w; }
    LDS_WAIT(); asm volatile("" ::: "memory");
#pragma unroll
    for (int j = 0; j < 4; ++j) { const int n = (lane >> 3) + 8 * j; const LAS float* s = scr + (8 * c) * 33 + n;
        u32x4 o; o.x = pk2(s[0 * 33] * g0.x, s[1 * 33] * g0.y); o.y = pk2(s[2 * 33] * g0.z, s[3 * 33] * g0.w); o.z = pk2(s[4 * 33] * g1.x, s[5 * 33] * g1.y); o.w = pk2(s[6 * 33] * g1.z, s[7 * 33] * g1.w);
        *(u32x4*)(I.WT + (size_t)(I.n0 + n) * I.ldt + I.k0 + 8 * c) = o; }
    LDS_WAIT(); asm volatile("" ::: "memory");
}
template <int NR> __device__ __forceinline__ void prep_rows(const float* __restrict__ xrow, const float* __restrict__ g, bf16* __restrict__ xnrow, const float* __restrict__ prow, bf16* __restrict__ pbrow, int lane) {
    f32x4 v[NR][4], pv[NR];
#pragma unroll
    for (int r = 0; r < NR; ++r) {
#pragma unroll
        for (int j = 0; j < 4; ++j) v[r][j] = ((const f32x4*)(xrow + (size_t)r * D))[lane + 64 * j];
        pv[r] = ((const f32x4*)(prow + (size_t)r * PLE))[lane]; }
    f32x4 gg[4];
#pragma unroll
    for (int j = 0; j < 4; ++j) gg[j] = ((const f32x4*)g)[lane + 64 * j];
#pragma unroll
    for (int r = 0; r < NR; ++r) { float s = 0.f;
#pragma unroll
        for (int j = 0; j < 4; ++j) s += pg8::sumsq4(v[r][j]);
        const float rstd = rsqrtf(wave_sum(s) * (1.f / D) + EPS);
        u32x2* o = (u32x2*)(xnrow + (size_t)r * D) + lane;
#pragma unroll
        for (int j = 0; j < 4; ++j) { u32x2 w; w.x = pk2(v[r][j].x * rstd * gg[j].x, v[r][j].y * rstd * gg[j].y); w.y = pk2(v[r][j].z * rstd * gg[j].z, v[r][j].w * rstd * gg[j].w); o[64 * j] = w; }
        u32x2 w; w.x = pk2(pv[r].x, pv[r].y); w.y = pk2(pv[r].z, pv[r].w); ((u32x2*)(pbrow + (size_t)r * D))[lane] = w; }
}
template <int NR> __device__ __forceinline__ void final_rows(const bf16* __restrict__ x3row, float* __restrict__ orow, const float* __restrict__ ss, const float* __restrict__ g, int row, int lane) {
    u32x4 xv[NR][2]; float sq[NR];
#pragma unroll
    for (int r = 0; r < NR; ++r) { sq[r] = ss[(size_t)(row + r) * 16 + (lane & 15)];
#pragma unroll
        for (int j = 0; j < 2; ++j) xv[r][j] = ((const u32x4*)(x3row + (size_t)r * D))[lane + 64 * j]; }
    f32x4 gg[4];
#pragma unroll
    for (int j = 0; j < 2; ++j) { gg[2 * j] = ((const f32x4*)g)[2 * lane + 128 * j]; gg[2 * j + 1] = ((const f32x4*)g)[2 * lane + 128 * j + 1]; }
#pragma unroll
    for (int r = 0; r < NR; ++r) { float q = sq[r];
        q += __shfl_xor(q, 1); q += __shfl_xor(q, 2); q += __shfl_xor(q, 4); q += __shfl_xor(q, 8);
        const float rstd = rsqrtf(q * (1.f / D) + EPS);
        f32x4* o = (f32x4*)(orow + (size_t)r * D) + 2 * lane;
#pragma unroll
        for (int j = 0; j < 2; ++j) { f32x4 v0, v1; pg8::unpack8(xv[r][j], v0, v1); o[128 * j] = v0 * rstd * gg[2 * j]; o[128 * j + 1] = v1 * rstd * gg[2 * j + 1]; } }
}

struct Args { const float* in[20]; float* out; unsigned char* ws; int ph_lo, ph_hi; };
typedef const __attribute__((address_space(4))) Args* KArgs;
__device__ __forceinline__ KArgs kargs() { KArgs p = (KArgs)__builtin_amdgcn_kernarg_segment_ptr(); asm volatile("" : "+s"(p)); return p; }
#if MK_PER_PHASE
#define IN(k) (ka->ph_lo <= (k) && (k) < ka->ph_hi)
#define GRID_BAR(k) do { } while (0)
#else
#define IN(k) true
#define GRID_BAR(k) do { if ((k) + 1 < N_PHASES) { XcdBarrier b_; b_.bar = (unsigned*)(ka->ws + WS_CTL) + CW_BAR; b_.x = xb_xcc_id(); b_.st = (volatile LAS unsigned*)(lds + MISC_OFF) + 8; xcd_barrier(b_); } } while (0)
#endif
#define WSPTRS(wsb) \
    bf16 *WIN = (bf16*)((wsb) + WS_WIN), *WBD = (bf16*)((wsb) + WS_WBD), *WBR = (bf16*)((wsb) + WS_WBR), *WOUT = (bf16*)((wsb) + WS_WOUT), *W1 = (bf16*)((wsb) + WS_W1), *W2 = (bf16*)((wsb) + WS_W2), *WPG = (bf16*)((wsb) + WS_WPG), *WPLE = (bf16*)((wsb) + WS_WPLE); \
    float* SS1 = (float*)((wsb) + WS_SS); float* SS2 = SS1 + (size_t)MG * 16; float* SS3 = SS2 + (size_t)MG * 16; \
    bf16 *XN = (bf16*)ka->out, *PB = (bf16*)ka->out + (size_t)M * D, *MIX = (bf16*)((wsb) + WS_MIX), *PROJ = (bf16*)((wsb) + WS_PROJ), *HID = (bf16*)((wsb) + WS_PROJ); \
    bf16 *YA = PROJ + O_QA, *YR = PROJ + O_VR; \
    (void)WIN; (void)WBD; (void)WBR; (void)WOUT; (void)W1; (void)W2; (void)WPG; (void)WPLE; (void)SS1; (void)SS2; (void)SS3; (void)PB; (void)XN; (void)YA; (void)YR; (void)MIX; (void)PROJ; (void)HID
#define LANEINFO() int tid_ = threadIdx.x; asm volatile("" : "+v"(tid_)); const int tid = tid_, lane = tid & 63, wave = __builtin_amdgcn_readfirstlane(tid >> 6), G = gridDim.x, gw = (int)blockIdx.x * NWAVES + wave, NGW = G * NWAVES; (void)lane; (void)gw; (void)NGW; (void)G

__global__ void __launch_bounds__(NWAVES * 64, 2) mk_fwd(Args args_unused) {
    extern __shared__ __attribute__((aligned(16))) unsigned char lds_raw[];
    LAS unsigned char* lds = (LAS unsigned char*)lds_raw;
    for (int u = threadIdx.x; u < (LDS_BYTES - LDSCTL_OFF) / 4; u += NWAVES * 64) ((LAS unsigned*)(lds + LDSCTL_OFF))[u] = 0u;
    __syncthreads();
    if (!MK_PER_PHASE) { KArgs ka = kargs(); (void)xcd_barrier_post((unsigned*)(ka->ws + WS_CTL) + CW_BAR, (volatile LAS unsigned*)(lds + MISC_OFF) + 8); }

    { KArgs ka = kargs();
    if (IN(0)) {
        LANEINFO(); unsigned char* ws = ka->ws; WSPTRS(ws);
        LAS float* scr = (LAS float*)(lds + wave * 16384);
        constexpr int I_IN = (D / 64) * (DIN / 32), I_SQ = (D / 64) * (D / 32), I_1 = (D / 64) * (FF / 32), I_2 = (FF / 64) * (D / 32), I_PL = (PLE / 64) * (D / 32);
        constexpr int NITEMS = I_IN + 4 * I_SQ + I_1 + I_2 + I_PL;
        auto decode = [&](int it) { P0Item I; int r = it, sh;
            if (r < I_IN) { I.W = ka->in[3]; I.gain = nullptr; I.WT = WIN; I.N = DIN; I.ldt = D; sh = 8; }
            else if ((r -= I_IN) < I_SQ) { I.W = ka->in[10]; I.gain = nullptr; I.WT = WBD; I.N = D; I.ldt = D; sh = 5; }
            else if ((r -= I_SQ) < I_SQ) { I.W = ka->in[11]; I.gain = nullptr; I.WT = WBR; I.N = D; I.ldt = D; sh = 5; }
            else if ((r -= I_SQ) < I_SQ) { I.W = ka->in[12]; I.gain = nullptr; I.WT = WOUT; I.N = D; I.ldt = D; sh = 5; }
            else if ((r -= I_SQ) < I_SQ) { I.W = ka->in[17]; I.gain = ka->in[16]; I.WT = WPG; I.N = D; I.ldt = D; sh = 5; }
            else if ((r -= I_SQ) < I_1) { I.W = ka->in[14]; I.gain = ka->in[13]; I.WT = W1; I.N = FF; I.ldt = D; sh = 7; }
            else if ((r -= I_1) < I_2) { I.W = ka->in[15]; I.gain = nullptr; I.WT = W2; I.N = D; I.ldt = FF; sh = 5; }
            else { r -= I_2; I.W = ka->in[18]; I.gain = nullptr; I.WT = WPLE; I.N = D; I.ldt = D; sh = 5; }
            I.k0 = 64 * (r >> sh); I.n0 = 32 * (r & ((1 << sh) - 1)); return I; };
        { int it = gw; P0Item I{}; f32x4 cur[10], nxt[10];
          if (it < NITEMS) { I = decode(it); p0_load(I, lane, cur); }
          for (; it + NGW < NITEMS; it += NGW) {
              const P0Item In = decode(it + NGW); p0_load(In, lane, nxt);
              p0_store(I, lane, cur, scr);
              I = In;
#pragma unroll
              for (int i = 0; i < 10; ++i) cur[i] = nxt[i]; }
          if (it < NITEMS) p0_store(I, lane, cur, scr); }
        const float* x = ka->in[0]; const float* p = ka->in[1]; const float* g_mix = ka->in[2];
        for (int m = gw * 4; m < M; m += NGW * 4) prep_rows<4>(x + (size_t)m * D, g_mix, XN + (size_t)m * D, p + (size_t)m * PLE, PB + (size_t)m * D, lane);
        GRID_BAR(0);
    } }
    { KArgs ka = kargs();
    if (IN(1)) {
        unsigned char* ws = ka->ws; WSPTRS(ws);
        pg8::Gemm gm{XN, WIN, XN, WIN, D, D, D, D}; pg8::StaticOrder So; So.init(M, PP, gridDim.x, (int)blockIdx.x, 1);
        pg8::EpiProj E{PROJ};
        pg8::gemm_phase<pg8::EpiProj, true>(lds, gm, So, E);
        GRID_BAR(1);
    } }
    { KArgs ka = kargs();
    if (IN(2)) {
        LANEINFO(); unsigned char* ws = ka->ws; WSPTRS(ws);
        const LamPtrs L{ka->in[4], ka->in[5], ka->in[6], ka->in[7]};
        const float lam = __builtin_bit_cast(float, __builtin_amdgcn_readfirstlane(__builtin_bit_cast(int, compute_lam(L, lane)))); const float* g_diff = ka->in[8]; const float* g_ret = ka->in[9];
        { unsigned* qhead = (unsigned*)(ws + WS_CTL) + CW_QUEUE; volatile LAS unsigned* slot = (volatile LAS unsigned*)(lds + MISC_OFF) + 16;
          constexpr int NCHAINS = NB * 4, NATT = NB * 8 * 16, NUNITS = NCHAINS + NATT;
          if (tid < 128) ((LAS float*)(lds + att::A_G))[tid] = g_diff[tid] * (1.f - LAM_INIT);
          unsigned nxt_ = 0u; if (tid == 0) nxt_ = __hip_atomic_fetch_add(qhead, 1u, __ATOMIC_RELAXED, __HIP_MEMORY_SCOPE_AGENT);
          for (int n_ = 0;; ++n_) {
              if (tid == 0) { slot[n_ & 1] = nxt_; }
              asm volatile("s_waitcnt lgkmcnt(0)\n\ts_barrier" ::: "memory"); const int item = (int)slot[n_ & 1];
              if (tid == 0) nxt_ = __hip_atomic_fetch_add(qhead, 1u, __ATOMIC_RELAXED, __HIP_MEMORY_SCOPE_AGENT);
              if (item >= NUNITS) break;
              if (item < NCHAINS) { ret::ret_chain(lds, PROJ, YR, item >> 2, item & 3, g_ret); continue; }
              const int a_ = item - NCHAINS, r_ = a_ & 1023, bh = r_ >> 2, qb = 4 * (3 - (a_ >> 10)) + 3 - (r_ & 3);
              att::attn_unit(lds, PROJ, YA, bh >> 3, bh & 7, qb, lam, g_diff);
          } }
        GRID_BAR(2);
    } }
    { KArgs ka = kargs();
    if (IN(3)) {
        unsigned char* ws = ka->ws; WSPTRS(ws);
        const bf16* WG = WIN + (size_t)W_GATE_ROW * D;
        pg8::Gemm gm{XN, WG, XN, WG, D, D, D, D}; pg8::StaticOrder So; So.init(M, 2 * D, gridDim.x, (int)blockIdx.x, 1);
        pg8::EpiGate E{PROJ + O_GA};
        pg8::gemm_phase<pg8::EpiGate, true>(lds, gm, So, E);
        GRID_BAR(3);
    } }
    { KArgs ka = kargs();
    if (IN(4)) {
        unsigned char* ws = ka->ws; WSPTRS(ws);
        pg8::Gemm gm{YA, WBD, YR, WBR, PP, D, D, D}; pg8::StaticOrder So; So.init(M, D, gridDim.x, (int)blockIdx.x, 2);
        pg8::EpiMix E{PROJ, MIX};
        pg8::gemm_phase<pg8::EpiMix, true>(lds, gm, So, E);
        GRID_BAR(4);
    } }
    { KArgs ka = kargs();
    if (IN(5)) {
        unsigned char* ws = ka->ws; WSPTRS(ws);
        pg8::Gemm gm{MIX, WOUT, MIX, WOUT, D, D, D, D}; pg8::StaticOrder So; So.init(M, D, gridDim.x, (int)blockIdx.x, 1);
        pg8::EpiRes<false> E{ka->in[0], XN, SS1};
        pg8::gemm_phase<pg8::EpiRes<false>, true>(lds, gm, So, E);
        GRID_BAR(5);
    } }
    { KArgs ka = kargs();
    if (IN(6)) {
        unsigned char* ws = ka->ws; WSPTRS(ws);
        pg8::Gemm gm{XN, W1, XN, W1, D, D, D, D}; pg8::StaticOrder So; So.init(M, FF, gridDim.x, (int)blockIdx.x, 1);
        pg8::EpiHid E{SS1, HID};
        pg8::gemm_phase<pg8::EpiHid, true>(lds, gm, So, E);
        GRID_BAR(6);
    } }
    { KArgs ka = kargs();
    if (IN(7)) {
        unsigned char* ws = ka->ws; WSPTRS(ws);
        pg8::Gemm gm{HID, W2, HID, W2, FF, FF, FF, FF}; pg8::StaticOrder So; So.init(M, D, gridDim.x, (int)blockIdx.x, 1);
        pg8::EpiRes<true> E{nullptr, XN, SS2};
        pg8::gemm_phase<pg8::EpiRes<true>, true>(lds, gm, So, E);
        GRID_BAR(7);
    } }
    { KArgs ka = kargs();
    if (IN(8)) {
        unsigned char* ws = ka->ws; WSPTRS(ws);
        pg8::Gemm gm{PB, WPLE, XN, WPG, D, D, PLE, D}; pg8::StaticOrder So; So.init(M, D, gridDim.x, (int)blockIdx.x, 2);
        pg8::EpiPle E{SS2, MIX, XN, SS3};
        pg8::gemm_phase<pg8::EpiPle, true>(lds, gm, So, E);
        GRID_BAR(8);
    } }
    { KArgs ka = kargs();
    if (IN(9)) {
        LANEINFO(); unsigned char* ws = ka->ws; WSPTRS(ws);
        float* og = ka->out; const float* g_final = ka->in[19];
        for (int m = gw * 4; m < M; m += NGW * 4) final_rows<4>(MIX + (size_t)m * D, og + (size_t)m * D, SS3, g_final, m, lane);
    } }
}

extern "C" void kernel_launch(void* const* d_in, const int* in_sizes, int n_in, void* d_out, int out_size, void* d_ws, size_t ws_size, hipStream_t stream) {
    static int grid = 0;
    if (grid == 0) {
        if (n_in != 20 || in_sizes[0] != M * D || out_size != M * D || ws_size < WS_END) { fprintf(stderr, "kernel_launch: unexpected shapes (n_in %d, ws %zu)\n", n_in, ws_size); grid = -1; return; }
        int dev = 0, cus = 0, per_cu = 0;
        if (hipGetDevice(&dev) != hipSuccess || hipDeviceGetAttribute(&cus, hipDeviceAttributeMultiprocessorCount, dev) != hipSuccess) { grid = -1; return; }
        if (hipFuncSetAttribute((const void*)mk_fwd, hipFuncAttributeMaxDynamicSharedMemorySize, LDS_BYTES) != hipSuccess) { fprintf(stderr, "kernel_launch: hipFuncSetAttribute failed\n"); grid = -1; return; }
        if (hipOccupancyMaxActiveBlocksPerMultiprocessor(&per_cu, (const void*)mk_fwd, NWAVES * 64, LDS_BYTES) != hipSuccess || per_cu < 1) { fprintf(stderr, "kernel_launch: occupancy query says %d\n", per_cu); (void)hipGetLastError(); grid = -1; return; }
        grid = cus;
    }
    if (grid < 0) return;
    if (hipMemsetAsync((char*)d_ws + WS_CTL, 0, CTL_ZERO_BYTES, stream) != hipSuccess) return;
    Args a{};
    for (int i = 0; i < 20; ++i) a.in[i] = (const float*)d_in[i];
    a.out = (float*)d_out; a.ws = (unsigned char*)d_ws;
#if MK_PER_PHASE
    for (int ph = 0; ph < N_PHASES; ++ph) { a.ph_lo = ph; a.ph_hi = ph + 1; hipLaunchKernelGGL(mk_fwd, dim3(grid), dim3(NWAVES * 64), LDS_BYTES, stream, a); }
#else
    a.ph_lo = 0; a.ph_hi = N_PHASES;
    hipLaunchKernelGGL(mk_fwd, dim3(grid), dim3(NWAVES * 64), LDS_BYTES, stream, a);
#endif
}
```
